# Optimizing an MI355X kernel written in HIP

```python
import math, functools
import jax, jax.numpy as jnp
from jax import lax
import numpy as np

D_MODEL = 1024
BATCH = 8
SEQ = 8192
DEPTH = 2
DEC_BATCH = 32
DEC_SEQ = 16
PAST_LEN = 4096

CHUNK = 64
HEAD_DIM = 64
H_A = 6
H_B = 6
G_C = 4
W_A = H_A * HEAD_DIM
W_B = H_B * HEAD_DIM
W_C = G_C * HEAD_DIM
MIX = W_A + W_B + W_C
Q_BLOCK = 128
GDN_CHUNK = CHUNK
CONV_K = 4
CM_LEN = 128
D_FF = -(-8 * D_MODEL // (3 * 256)) * 256
FORGET_BIAS = 3.0
ATTN_SCALE = HEAD_DIM ** -0.5
SPLIT_SIZES = (W_A, W_A, W_A, H_A, 3 * W_B, H_B, H_B, W_B, W_C, W_C)
SPLIT_IDX = tuple(int(i) for i in np.cumsum(SPLIT_SIZES)[:-1])
D_IN = sum(SPLIT_SIZES)

kernel_name = 'hybrid_stream_fox_gdn_sgu_step'


def rmsnorm(x, g, eps=1e-6):
    xf = x.astype(jnp.float32)
    y = xf * lax.rsqrt(jnp.mean(xf * xf, axis=-1, keepdims=True) + eps)
    return (y * g.astype(jnp.float32)).astype(x.dtype)


def layernorm(x, g, b, eps=1e-5):
    xf = x.astype(jnp.float32)
    mu = jnp.mean(xf, axis=-1, keepdims=True)
    var = jnp.mean(jnp.square(xf - mu), axis=-1, keepdims=True)
    return ((xf - mu) * lax.rsqrt(var + eps) * g.astype(jnp.float32) + b.astype(jnp.float32)).astype(x.dtype)


def l2norm(x, eps=1e-6):
    return x * lax.rsqrt(jnp.sum(x * x, axis=-1, keepdims=True) + eps)


def fox_attend_prompt(q, k, v, logf):
    B, S, H, Dh = q.shape
    nb = S // Q_BLOCK
    cT = jnp.cumsum(logf, axis=1).transpose(0, 2, 1)
    qb = q.reshape(B, nb, Q_BLOCK, H, Dh).swapaxes(0, 1)
    cqb = cT.reshape(B, H, nb, Q_BLOCK).transpose(2, 0, 1, 3)
    kpos = jnp.arange(S)

    def block(args):
        qi, cqi, i = args
        s = jnp.einsum('bqhd,bkhd->bhqk', qi, k, preferred_element_type=jnp.float32) * ATTN_SCALE
        s = s + cqi[..., :, None] - cT[..., None, :]
        qpos = i * Q_BLOCK + jnp.arange(Q_BLOCK)
        s = jnp.where(kpos[None, :] <= qpos[:, None], s, -jnp.inf)
        p = jax.nn.softmax(s, axis=-1)
        return jnp.einsum('bhqk,bkhd->bqhd', p.astype(v.dtype), v)

    o = lax.map(block, (qb, cqb, jnp.arange(nb)))
    return o.swapaxes(0, 1).reshape(B, S, H, Dh)


def fox_attend_sample(q, k, v, logf, ck, cv, clogf):
    B, n, H, Dh = q.shape
    P = ck.shape[1]
    kk = jnp.concatenate([ck.astype(k.dtype), k], axis=1)
    vv = jnp.concatenate([cv.astype(v.dtype), v], axis=1)
    c = jnp.cumsum(jnp.concatenate([clogf.astype(jnp.float32), logf], axis=1), axis=1).transpose(0, 2, 1)
    s = jnp.einsum('bqhd,bkhd->bhqk', q, kk, preferred_element_type=jnp.float32) * ATTN_SCALE
    s = s + c[..., P:, None] - c[..., None, :]
    mask = jnp.arange(P + n)[None, :] <= (P + jnp.arange(n))[:, None]
    p = jax.nn.softmax(jnp.where(mask, s, -jnp.inf), axis=-1)
    return jnp.einsum('bhqk,bkhd->bqhd', p.astype(vv.dtype), vv)


def short_conv(xin, prev, w):
    T = xin.shape[1]
    xp = jnp.concatenate([prev.astype(xin.dtype), xin], axis=1)
    y = xp[:, 0:T] * w[0]
    for i in range(1, CONV_K):
        y = y + xp[:, i:i + T] * w[i]
    return y, xp[:, -(CONV_K - 1):]


def gdn_chunked(q, k, v, beta, gl, S0):
    L = q.shape[2]
    Gh = jnp.cumsum(gl, axis=2).transpose(0, 1, 3, 2)
    incl = jnp.tril(jnp.ones((L, L), dtype=bool))
    strict = jnp.tril(jnp.ones((L, L), dtype=bool), -1)
    diff = Gh[..., :, None] - Gh[..., None, :]
    dec = jnp.exp(jnp.where(incl, diff, -jnp.inf))
    bh = beta.transpose(0, 1, 3, 2)
    kk = jnp.einsum('bnihd,bnjhd->bnhij', k, k)
    A = jnp.where(strict, bh[..., :, None] * kk * dec, 0.0)
    IA = A + jnp.eye(L, dtype=A.dtype)
    kt = k.transpose(0, 1, 3, 2, 4)
    rhs_v = v.transpose(0, 1, 3, 2, 4) * bh[..., None]
    rhs_k = kt * (bh * jnp.exp(Gh))[..., None]
    Uv = lax.linalg.triangular_solve(IA, rhs_v, left_side=True, lower=True, unit_diagonal=True)
    W = lax.linalg.triangular_solve(IA, rhs_k, left_side=True, lower=True, unit_diagonal=True)
    qk = jnp.einsum('bnihd,bnjhd->bnhij', q, k) * dec
    qg = q.transpose(0, 1, 3, 2, 4) * jnp.exp(Gh)[..., None]
    kdec = kt * jnp.exp(Gh[..., -1:] - Gh)[..., None]
    gL = jnp.exp(Gh[..., -1])

    def step(S, inp):
        uv_c, w_c, qk_c, qg_c, kd_c, gl_c = inp
        U = uv_c - jnp.einsum('bhld,bhde->bhle', w_c, S)
        o = jnp.einsum('bhld,bhde->bhle', qg_c, S) + jnp.einsum('bhij,bhje->bhie', qk_c, U)
        S = S * gl_c[..., None, None] + jnp.einsum('bhld,bhle->bhde', kd_c, U)
        return S, o

    xs = tuple(a.swapaxes(0, 1) for a in (Uv, W, qk, qg, kdec, gL))
    S, o = lax.scan(step, S0, xs)
    return o.transpose(1, 0, 3, 2, 4), S


def spatial_gate(u, v, w_s, b_s):
    L = u.shape[2]
    pos = jnp.arange(L)
    mask = (pos[None, :] // CHUNK) <= (pos[:, None] // CHUNK)
    w = jnp.where(mask, w_s[:, :L, :L], 0.0)
    s = jnp.einsum('gij,bnjgc->bnigc', w, v) + b_s[:, :L].T[None, None, :, :, None]
    return u * s


def layer(x, p, conv_prev, S0, attend, gdn_len, cm_len):
    B, T, _ = x.shape
    f32 = jnp.float32
    h = rmsnorm(x, p['g_pre_mix'])
    z = h @ p['w_in']
    aq, ak, av, af, bqkv, ba, bb, bz, cu, cv = jnp.split(z, SPLIT_IDX, axis=-1)
    qa = aq.reshape(B, T, H_A, HEAD_DIM)
    ka = ak.reshape(B, T, H_A, HEAD_DIM)
    va = av.reshape(B, T, H_A, HEAD_DIM)
    logf = jax.nn.log_sigmoid(af.astype(f32) + p['b_f'].astype(f32))
    oa = rmsnorm(attend(qa, ka, va, logf).reshape(B, T, W_A), p['g_a_out']).astype(x.dtype)
    yc, conv_new = short_conv(bqkv, conv_prev, p['conv_w'])
    yc = jax.nn.silu(yc.astype(f32))
    qb, kb, vb = jnp.split(yc, 3, axis=-1)
    qb = l2norm(qb.reshape(B, T, H_B, HEAD_DIM)) * ATTN_SCALE
    kb = l2norm(kb.reshape(B, T, H_B, HEAD_DIM))
    vb = vb.reshape(B, T, H_B, HEAD_DIM)
    beta = jax.nn.sigmoid(bb.astype(f32))
    gl = -jnp.exp(p['a_log'].astype(f32)) * jax.nn.softplus(ba.astype(f32) + p['dt_bias'].astype(f32))
    nc = T // gdn_len
    rs = lambda t: t.reshape((B, nc, gdn_len) + t.shape[2:])
    ob, S_new = gdn_chunked(rs(qb), rs(kb), rs(vb), rs(beta), rs(gl), S0.astype(f32))
    ob = rmsnorm(ob.reshape(B, T, H_B, HEAD_DIM), p['g_b_out']) * jax.nn.silu(bz.astype(f32).reshape(B, T, H_B, HEAD_DIM))
    ob = ob.reshape(B, T, W_B).astype(x.dtype)
    u = jax.nn.gelu(cu)
    vn = layernorm(jax.nn.gelu(cv), p['g_cv'], p['b_cv'])
    nm = T // cm_len
    rc = lambda t: t.reshape(B, nm, cm_len, G_C, W_C // G_C)
    oc = spatial_gate(rc(u), rc(vn), p['w_s'], p['b_s']).reshape(B, T, W_C)
    oc = rmsnorm(oc, p['g_c_out']).astype(x.dtype)
    m = jnp.concatenate([oa, ob, oc], axis=-1) @ p['w_out']
    x = x + rmsnorm(m, p['g_post_mix'])
    gate, up = jnp.split(rmsnorm(x, p['g_pre_ffn']) @ p['w_ffn_in'], 2, axis=-1)
    x = x + rmsnorm((jax.nn.silu(gate) * up) @ p['w_ffn_out'], p['g_post_ffn'])
    return x, (ka, va, logf, conv_new, S_new, vn)


def setup_inputs(seed: int = 0) -> dict:
    key = jax.random.key(seed)
    ks = jax.random.split(key, 26)
    f32 = jnp.float32
    nrm = lambda k, shape, s: jax.random.normal(k, shape, f32) * s
    gain = lambda k, shape: 1.0 + 0.05 * jax.random.normal(k, shape, f32)
    x_prompt = nrm(ks[0], (BATCH, SEQ, D_MODEL), 1.0)
    x_sample = nrm(ks[1], (DEC_BATCH, DEC_SEQ, D_MODEL), 1.0)
    cache_a_k = nrm(ks[2], (DEPTH, DEC_BATCH, PAST_LEN, H_A, HEAD_DIM), 1.0)
    cache_a_v = nrm(ks[3], (DEPTH, DEC_BATCH, PAST_LEN, H_A, HEAD_DIM), 1.0)
    cache_a_logf = jax.nn.log_sigmoid(FORGET_BIAS + nrm(ks[4], (DEPTH, DEC_BATCH, PAST_LEN, H_A), 1.0))
    state_b_conv = nrm(ks[5], (DEPTH, DEC_BATCH, CONV_K - 1, 3 * W_B), 1.0)
    state_b_S = nrm(ks[6], (DEPTH, DEC_BATCH, H_B, HEAD_DIM, HEAD_DIM), 0.1)
    g_pre_mix = gain(ks[7], (DEPTH, D_MODEL))
    w_in = nrm(ks[8], (DEPTH, D_MODEL, D_IN), D_MODEL ** -0.5)
    b_f = FORGET_BIAS + nrm(ks[9], (DEPTH, H_A), 0.1)
    conv_w = nrm(ks[10], (DEPTH, CONV_K, 3 * W_B), 0.5)
    a_log = jnp.log(jax.random.uniform(ks[11], (DEPTH, H_B), f32, 1.0, 16.0))
    dt = jnp.exp(jax.random.uniform(ks[12], (DEPTH, H_B), f32, math.log(1e-3), math.log(1e-1)))
    dt_bias = dt + jnp.log(-jnp.expm1(-dt))
    g_b_out = gain(ks[13], (DEPTH, HEAD_DIM))
    g_a_out = gain(ks[14], (DEPTH, W_A))
    g_cv = gain(ks[15], (DEPTH, W_C))
    b_cv = nrm(ks[16], (DEPTH, W_C), 0.02)
    w_s = nrm(ks[17], (DEPTH, G_C, CM_LEN, CM_LEN), CM_LEN ** -0.5)
    b_s = 1.0 + nrm(ks[18], (DEPTH, G_C, CM_LEN), 0.1)
    g_c_out = gain(ks[19], (DEPTH, W_C))
    w_out = nrm(ks[20], (DEPTH, MIX, D_MODEL), MIX ** -0.5)
    g_post_mix = gain(ks[21], (DEPTH, D_MODEL))
    g_pre_ffn = gain(ks[22], (DEPTH, D_MODEL))
    w_ffn_in = nrm(ks[23], (DEPTH, D_MODEL, 2 * D_FF), D_MODEL ** -0.5)
    w_ffn_out = nrm(ks[24], (DEPTH, D_FF, D_MODEL), D_FF ** -0.5)
    g_post_ffn = gain(ks[25], (DEPTH, D_MODEL))
    return {'x_prompt': x_prompt, 'x_sample': x_sample, 'cache_a_k': cache_a_k, 'cache_a_v': cache_a_v,
            'cache_a_logf': cache_a_logf, 'state_b_conv': state_b_conv, 'state_b_S': state_b_S,
            'g_pre_mix': g_pre_mix, 'w_in': w_in, 'b_f': b_f, 'conv_w': conv_w, 'a_log': a_log,
            'dt_bias': dt_bias, 'g_b_out': g_b_out, 'g_a_out': g_a_out, 'g_cv': g_cv, 'b_cv': b_cv,
            'w_s': w_s, 'b_s': b_s, 'g_c_out': g_c_out, 'w_out': w_out, 'g_post_mix': g_post_mix,
            'g_pre_ffn': g_pre_ffn, 'w_ffn_in': w_ffn_in, 'w_ffn_out': w_ffn_out, 'g_post_ffn': g_post_ffn}


def reference(x_prompt, x_sample, cache_a_k, cache_a_v, cache_a_logf, state_b_conv, state_b_S,
              g_pre_mix, w_in, b_f, conv_w, a_log, dt_bias, g_b_out, g_a_out, g_cv, b_cv,
              w_s, b_s, g_c_out, w_out, g_post_mix, g_pre_ffn, w_ffn_in, w_ffn_out, g_post_ffn):
    bp = x_prompt.shape[0]
    n_new = x_sample.shape[1]
    yp, ys = x_prompt, x_sample
    outs_p, outs_s = [], []
    for l in range(DEPTH):
        p = dict(g_pre_mix=g_pre_mix[l], w_in=w_in[l], b_f=b_f[l], conv_w=conv_w[l], a_log=a_log[l],
                 dt_bias=dt_bias[l], g_b_out=g_b_out[l], g_a_out=g_a_out[l], g_cv=g_cv[l], b_cv=b_cv[l],
                 w_s=w_s[l], b_s=b_s[l], g_c_out=g_c_out[l], w_out=w_out[l], g_post_mix=g_post_mix[l],
                 g_pre_ffn=g_pre_ffn[l], w_ffn_in=w_ffn_in[l], w_ffn_out=w_ffn_out[l], g_post_ffn=g_post_ffn[l])
        conv0 = jnp.zeros((bp, CONV_K - 1, 3 * W_B), x_prompt.dtype)
        S0 = jnp.zeros((bp, H_B, HEAD_DIM, HEAD_DIM), jnp.float32)
        yp, st_p = layer(yp, p, conv0, S0, fox_attend_prompt, GDN_CHUNK, CM_LEN)
        attend_s = functools.partial(fox_attend_sample, ck=cache_a_k[l], cv=cache_a_v[l], clogf=cache_a_logf[l])
        ys, st_s = layer(ys, p, state_b_conv[l], state_b_S[l], attend_s, n_new, n_new)
        outs_p.append(st_p)
        outs_s.append(st_s)
    stk = lambda outs, i: jnp.stack([o[i] for o in outs], axis=0)
    new_a_k_prompt = stk(outs_p, 0)
    new_a_v_prompt = stk(outs_p, 1)
    new_a_logf_prompt = stk(outs_p, 2)
    new_b_conv_prompt = stk(outs_p, 3)
    new_b_S_prompt = stk(outs_p, 4)
    new_a_k_sample = stk(outs_s, 0)
    new_a_v_sample = stk(outs_s, 1)
    new_a_logf_sample = stk(outs_s, 2)
    new_b_conv_sample = stk(outs_s, 3)
    new_b_S_sample = stk(outs_s, 4)
    new_c_v_sample = stk(outs_s, 5)
    return (yp, ys, new_a_k_prompt, new_a_v_prompt, new_a_logf_prompt, new_b_conv_prompt, new_b_S_prompt,
            new_a_k_sample, new_a_v_sample, new_a_logf_sample, new_b_conv_sample, new_b_S_sample, new_c_v_sample)
```

```cpp
#include <hip/hip_runtime.h>
#include <cstdio>
#include <cstdint>
namespace pg8 {
#define PG8_LAS __attribute__((address_space(3)))
typedef unsigned short bf16_t;
typedef short bf16x8 __attribute__((ext_vector_type(8)));
typedef float f32x4 __attribute__((ext_vector_type(4)));
typedef unsigned u32x4 __attribute__((ext_vector_type(4)));
constexpr int BM = 256, BK = 64, HALF = 128, HTB = HALF * BK * 2  , STAGE_BYTES = 8 * HTB, NXCD = 8, WGM = 8;

__host__ __device__ __forceinline__ int lds_byte(int r, int c) { const int st = (r >> 4) * 2 + (c >> 5), rr = r & 15, cc = c & 31, ob = rr * 64 + cc * 2; return st * 1024 + (ob ^ (((ob >> 9) & 1) << 5)); }
__host__ __device__ __forceinline__ void stage_rc(int b, int& R, int& C) { const int st = b / 1024, sb = b % 1024, swz = sb ^ (((sb >> 9) & 1) << 5); R = (st >> 1) * 16 + swz / 64; C = (st & 1) * 32 + (swz % 64) / 2; }
__host__ __device__ __forceinline__ int perm32(int rho) { const int n = rho >> 4, i = rho & 15; return 8 * (i >> 2) + 4 * n + (i & 3); }

struct Unit { int pm, pn; };
struct Gemm { const bf16_t* A; const bf16_t* Bt; int M, N, K; int ld; const float* ssq; };

struct StaticOrder {
    int nM, nN, nwg, G, c;
    __host__ __device__ void init(int M, int N, int G_, int c_) { nM = M / BM; nN = N / BM; nwg = nM * nN; G = G_; c = c_; }
    __host__ __device__ bool next(int i, Unit& u) const {
        const long L = (long)i * G + c; if (L >= nwg) return false;
        int wgid = (int)L; { const int q = nwg / NXCD, r = nwg % NXCD, xcd = wgid % NXCD, off = wgid / NXCD; wgid = (xcd < r ? xcd * (q + 1) : r * (q + 1) + (xcd - r) * q) + off; }
        const int nig = WGM * nN, gid = wgid / nig, fm = gid * WGM, gsz = (nM - fm) < WGM ? (nM - fm) : WGM;
        u.pm = fm + ((wgid % nig) % gsz); u.pn = (wgid % nig) / gsz; return true;
    }
    __device__ __forceinline__ void a_ready(const Unit&) const {}
    __device__ __forceinline__ void done(const Unit&) const {}
};

__device__ __forceinline__ unsigned cvt_pk_bf16(float lo, float hi) { unsigned r; asm volatile("v_cvt_pk_bf16_f32 %0, %1, %2" : "=v"(r) : "v"(lo), "v"(hi)); return r; }
#define MFMA_SETTLE4(a, b, c, d) asm volatile("s_nop 15\n\ts_nop 7" : "+v"(a), "+v"(b), "+v"(c), "+v"(d))
typedef float f32x2 __attribute__((ext_vector_type(2)));
typedef float f32x4e __attribute__((ext_vector_type(4)));
__device__ __forceinline__ float silu_f(float x) { return x * __builtin_amdgcn_rcpf(1.f + __builtin_amdgcn_exp2f(-1.4426950408889634f * x)); }
__device__ __forceinline__ float gelu_tanh_f(float x) { const float u2 = 1.5957691216057308f * (x + 0.044715f * x * x * x); return x * __builtin_amdgcn_rcpf(1.f + __builtin_amdgcn_exp2f(-1.4426950408889634f * u2)); }
__device__ __forceinline__ float softplus_f(float x) { return fmaxf(x, 0.f) + log1pf(__expf(-fabsf(x))); }
struct EpiPlain {
    static constexpr bool PERM = true, AFTER_DRAIN = false;
    bf16_t* O; int ldc;
    __device__ __forceinline__ void operator()(const f32x4 (&acc)[2][2][4][2], const Unit& u0, int wr, int wc, int fr, int fq) const {
        Unit u = u0; asm volatile("s_nop 15\n\ts_nop 7" : "+s"(u.pm), "+s"(u.pn));
        const int row0 = u.pm * BM + wr * 64 + fr, col0 = u.pn * BM + wc * 32 + 8 * fq;
#pragma unroll
        for (int ai = 0; ai < 2; ++ai)
#pragma unroll
            for (int m = 0; m < 4; ++m) { bf16_t* rowp = O + (size_t)(row0 + ai * HALF + m * 16) * ldc + col0;
#pragma unroll
                for (int bj = 0; bj < 2; ++bj) { const f32x4 v0 = acc[ai][bj][m][0], v1 = acc[ai][bj][m][1];
                    u32x4 w; w.x = cvt_pk_bf16(v0[0], v0[1]); w.y = cvt_pk_bf16(v0[2], v0[3]); w.z = cvt_pk_bf16(v1[0], v1[1]); w.w = cvt_pk_bf16(v1[2], v1[3]);
                    *(u32x4*)(rowp + bj * HALF) = w; } }
    }
};
struct EpiF32 {
    static constexpr bool PERM = true, AFTER_DRAIN = false;
    float* O; int ldc;
    __device__ __forceinline__ void operator()(const f32x4 (&acc)[2][2][4][2], const Unit& u0, int wr, int wc, int fr, int fq) const {
        Unit u = u0; asm volatile("" : "+s"(u.pm), "+s"(u.pn));
        const int row0 = u.pm * BM + wr * 64 + fr, col0 = u.pn * BM + wc * 32 + 8 * fq;
#pragma unroll
        for (int ai = 0; ai < 2; ++ai)
#pragma unroll
            for (int m = 0; m < 4; ++m) { float* rowp = O + (size_t)(row0 + ai * HALF + m * 16) * ldc + col0;
#pragma unroll
                for (int bj = 0; bj < 2; ++bj) { *(f32x4*)(rowp + bj * HALF) = acc[ai][bj][m][0]; *(f32x4*)(rowp + bj * HALF + 4) = acc[ai][bj][m][1]; } }
    }
};
struct EpiSwiglu {
    static constexpr bool PERM = true, AFTER_DRAIN = false;
    bf16_t* O; int ldc;
    __device__ __forceinline__ void operator()(const f32x4 (&acc)[2][2][4][2], const Unit& u0, int wr, int wc, int fr, int fq) const {
        Unit u = u0; asm volatile("" : "+s"(u.pm), "+s"(u.pn));
        const int row0 = u.pm * BM + wr * 64 + fr, col0 = u.pn * HALF + wc * 32 + 8 * fq;
#pragma unroll
        for (int ai = 0; ai < 2; ++ai)
#pragma unroll
            for (int m = 0; m < 4; ++m) { bf16_t* rowp = O + (size_t)(row0 + ai * HALF + m * 16) * ldc + col0;
                const f32x4 g0 = acc[ai][0][m][0], g1 = acc[ai][0][m][1], u0 = acc[ai][1][m][0], u1 = acc[ai][1][m][1];
                u32x4 w; w.x = cvt_pk_bf16(silu_f(g0[0]) * u0[0], silu_f(g0[1]) * u0[1]); w.y = cvt_pk_bf16(silu_f(g0[2]) * u0[2], silu_f(g0[3]) * u0[3]);
                w.z = cvt_pk_bf16(silu_f(g1[0]) * u1[0], silu_f(g1[1]) * u1[1]); w.w = cvt_pk_bf16(silu_f(g1[2]) * u1[2], silu_f(g1[3]) * u1[3]);
                *(u32x4*)rowp = w; }
    }
};
constexpr int SM_ROWS = 66048;
struct EpiIn {
    static constexpr bool PERM = true, AFTER_DRAIN = false;
    bf16_t *Q, *K, *V, *BQKV, *BZ, *CU, *CV; float* SM;
    float *okp, *ovp, *oks, *ovs;
    int mp; float qscale;
    template <int BJ> __device__ __forceinline__ void half(const f32x4 (&acc)[2][2][4][2], const Unit& u, int wr, int wc, int fr, int fq) const {
        const int rloc = wr * 64 + fr, c8 = wc * 32 + 8 * fq;
        const bool prompt = u.pm * BM < mp;
        const int hh = 2 * u.pn + BJ;
        int mode; bf16_t* dst; int ld; float* fdst = nullptr;
        if (hh < 3) { mode = 1; dst = Q + hh * 128; ld = 384; }
        else if (hh < 6) { mode = 2; dst = K + (hh - 3) * 128; ld = 384; fdst = (prompt ? okp : oks - (size_t)mp * 384) + (hh - 3) * 128; }
        else if (hh < 9) { mode = 2; dst = V + (hh - 6) * 128; ld = 384; fdst = (prompt ? ovp : ovs - (size_t)mp * 384) + (hh - 6) * 128; }
        else if (hh < 18) { mode = 0; dst = BQKV + (hh - 9) * 128; ld = 1152; }
        else if (hh < 21) { mode = 3; dst = BZ + (hh - 18) * 128; ld = 384; }
        else if (hh < 23) { mode = 4; dst = CU + (hh - 21) * 128; ld = 256; }
        else if (hh < 25) { mode = 4; dst = CV + (hh - 23) * 128; ld = 256; }
        else { mode = 5; dst = nullptr; ld = 0; }
        if (mode != 5) {
#pragma unroll
            for (int ai = 0; ai < 2; ++ai)
#pragma unroll
                for (int m = 0; m < 4; ++m) { const int row = u.pm * BM + ai * HALF + m * 16 + rloc;
                    f32x4 v0 = acc[ai][BJ][m][0], v1 = acc[ai][BJ][m][1];
                    if (mode == 2) { float* fp = fdst + (size_t)row * 384 + c8; *(f32x4*)fp = v0; *(f32x4*)(fp + 4) = v1; }
                    if (mode == 1) { v0 = v0 * qscale; v1 = v1 * qscale; }
                    if (mode == 3) {
#pragma unroll
                        for (int e = 0; e < 4; ++e) { v0[e] = silu_f(v0[e]); v1[e] = silu_f(v1[e]); } }
                    if (mode == 4) {
#pragma unroll
                        for (int e = 0; e < 4; ++e) { v0[e] = gelu_tanh_f(v0[e]); v1[e] = gelu_tanh_f(v1[e]); } }
                    u32x4 w; w.x = cvt_pk_bf16(v0[0], v0[1]); w.y = cvt_pk_bf16(v0[2], v0[3]); w.z = cvt_pk_bf16(v1[0], v1[1]); w.w = cvt_pk_bf16(v1[2], v1[3]);
                    *(u32x4*)(dst + (size_t)row * ld + c8) = w; }
        } else if (wc == 0 && fq < 3) {
#pragma unroll
            for (int ai = 0; ai < 2; ++ai)
#pragma unroll
                for (int m = 0; m < 4; ++m) { const int row = u.pm * BM + ai * HALF + m * 16 + rloc; float* sp = SM + (size_t)(8 * fq) * SM_ROWS + row; const f32x4 v0 = acc[ai][BJ][m][0], v1 = acc[ai][BJ][m][1];
                    sp[0] = v0[0]; sp[SM_ROWS] = v0[1]; sp[2 * (size_t)SM_ROWS] = v0[2]; sp[3 * (size_t)SM_ROWS] = v0[3]; sp[4 * (size_t)SM_ROWS] = v1[0]; sp[5 * (size_t)SM_ROWS] = v1[1]; sp[6 * (size_t)SM_ROWS] = v1[2]; sp[7 * (size_t)SM_ROWS] = v1[3]; }
        }
    }
    __device__ __forceinline__ void operator()(const f32x4 (&acc)[2][2][4][2], const Unit& u0, int wr, int wc, int fr, int fq) const {
        Unit u = u0; asm volatile("s_nop 15\n\ts_nop 7" : "+s"(u.pm), "+s"(u.pn));
        half<0>(acc, u, wr, wc, fr, fq); half<1>(acc, u, wr, wc, fr, fq); }
};

template <class Epi, class Sched, bool ALIGN_EPI = false, bool SP2 = false, bool RS = false>
__device__ __forceinline__ void gemm_phase(PG8_LAS unsigned char* lds, const Gemm g, const Sched& S, const Epi& E) {
    int tid = threadIdx.x; asm volatile("" : "+v"(tid));
    const int wid = __builtin_amdgcn_readfirstlane(tid >> 6), lane = tid & 63, wr = wid >> 2, wc = wid & 3, fr = lane & 15, fq = lane >> 4;
    const int K = g.K, nt = K / BK, LD = g.ld ? g.ld : g.K;
    unsigned voffA[2], voffB[2];
#pragma unroll
    for (int i = 0; i < 2; ++i) { int R, C; stage_rc(tid * 16 + i * 8192, R, C); const int Rb = Epi::PERM ? ((R & ~31) + perm32(R & 31)) : R;
        voffA[i] = (unsigned)(R * LD + C) * 2u; voffB[i] = (unsigned)(Rb * LD + C) * 2u; }
    const size_t kstep = (size_t)(BK * 2);
    const size_t hstep = (size_t)HALF * LD * 2;
    const size_t tstep = 2 * hstep;
    const unsigned ldsw = (unsigned)wid * 1024u;
    const int aoff = lds_byte(wr * 64 + fr, fq * 8), boff = lds_byte(wc * 32 + fr, fq * 8);
#define PG8_SA(b, h) (((b) * 2 + (h)) * HTB)
#define PG8_SB(b, h) ((4 + (b) * 2 + (h)) * HTB)
#define PG8_STAGE(bufoff, gbase, voff) do { _Pragma("unroll") for (int _i = 0; _i < 2; ++_i) \
        __builtin_amdgcn_global_load_lds((const unsigned*)((const char*)(gbase) + (voff)[_i]), (PG8_LAS unsigned*)(lds + (bufoff) + ldsw + _i * 8192), 16, 0, 0); } while (0)
#define PG8_LDA(dst, b, h) do { _Pragma("unroll") for (int m = 0; m < 4; ++m) _Pragma("unroll") for (int k = 0; k < 2; ++k) dst[m][k] = *(const PG8_LAS bf16x8*)(lds + PG8_SA(b, h) + aoff + m * 2048 + k * 1024); } while (0)
#define PG8_LDB(dst, b, h) do { _Pragma("unroll") for (int n = 0; n < 2; ++n) _Pragma("unroll") for (int k = 0; k < 2; ++k) dst[n][k] = *(const PG8_LAS bf16x8*)(lds + PG8_SB(b, h) + boff + n * 2048 + k * 1024); } while (0)
#define PG8_MMA(ai, bj, At, Bt) do { __builtin_amdgcn_s_setprio(1); _Pragma("unroll") for (int m = 0; m < 4; ++m) _Pragma("unroll") for (int n = 0; n < 2; ++n) _Pragma("unroll") for (int k = 0; k < 2; ++k) \
        acc[ai][bj][m][n] = __builtin_amdgcn_mfma_f32_16x16x32_bf16(Bt[n][k], At[m][k], acc[ai][bj][m][n], 0, 0, 0); __builtin_amdgcn_s_setprio(0); } while (0)
#define PG8_WAIT_V(n) asm volatile("s_waitcnt vmcnt(" #n ")" ::: "memory")
#define PG8_WAIT_L(n) asm volatile("s_waitcnt lgkmcnt(" #n ")" ::: "memory")
#define PG8_BAR __builtin_amdgcn_s_barrier()
#define PG8_SCHED __builtin_amdgcn_sched_barrier(0)
    Unit cur, nxt; int ui = 0;
    if (!S.next(0, cur)) return;
    f32x4 acc[2][2][4][2];
#pragma unroll
    for (int a = 0; a < 2; ++a)
#pragma unroll
        for (int b = 0; b < 2; ++b)
#pragma unroll
            for (int m = 0; m < 4; ++m)
#pragma unroll
                for (int n = 0; n < 2; ++n) acc[a][b][m][n] = (f32x4){0.f, 0.f, 0.f, 0.f};
    bf16x8 At[4][2], B0[2][2], B1[2][2]; f32x4 rsa, rsb;
    const char* cA = (const char*)g.A + (size_t)cur.pm * tstep; const char* cB = (const char*)g.Bt + (size_t)cur.pn * tstep;
    S.a_ready(cur);
    if constexpr (SP2) {
        PG8_STAGE(PG8_SB(0, 0), cB, voffB); PG8_STAGE(PG8_SB(0, 1), cB + hstep, voffB); PG8_STAGE(PG8_SA(0, 0), cA, voffA); PG8_STAGE(PG8_SA(0, 1), cA + hstep, voffA);
        if (wr == 1) PG8_BAR;
        PG8_WAIT_V(2); PG8_BAR;
        PG8_STAGE(PG8_SB(1, 0), cB + kstep, voffB); PG8_STAGE(PG8_SA(1, 0), cA + kstep, voffA); PG8_STAGE(PG8_SB(1, 1), cB + hstep + kstep, voffB);
        PG8_WAIT_V(6); PG8_BAR;
    } else {
        PG8_STAGE(PG8_SB(0, 0), cB, voffB); PG8_STAGE(PG8_SA(0, 0), cA, voffA); PG8_STAGE(PG8_SB(0, 1), cB + hstep, voffB); PG8_STAGE(PG8_SA(0, 1), cA + hstep, voffA);
        if (wr == 1) PG8_BAR;
        PG8_WAIT_V(4); PG8_BAR;
        PG8_STAGE(PG8_SB(1, 0), cB + kstep, voffB); PG8_STAGE(PG8_SA(1, 0), cA + kstep, voffA); PG8_STAGE(PG8_SB(1, 1), cB + hstep + kstep, voffB);
        PG8_WAIT_V(6); PG8_BAR;
    }
    for (;;) {
        const bool has_next = S.next(ui + 1, nxt);
        const char* nA = has_next ? (const char*)g.A + (size_t)nxt.pm * tstep : cA; const char* nB = has_next ? (const char*)g.Bt + (size_t)nxt.pn * tstep : cB;
        for (int t = 0; t < nt; t += 2) {
            const bool last = (t == nt - 2);
            if constexpr (RS) {
                PG8_LAS float* rst = (PG8_LAS float*)(lds + STAGE_BYTES);
                if (t == 2 && wid < 4) { const float* p = g.ssq + (size_t)(cur.pm * BM + tid) * 8; rsa = *(const f32x4*)p; rsb = *(const f32x4*)(p + 4); }
                if (t == 4 && wid < 4) rst[tid] = 1.0f / sqrtf((((rsa[0] + rsa[1]) + (rsa[2] + rsa[3])) + (rsb[0] + rsb[1])) * (1.0f / 384.0f) + 1e-6f);
                if (t == 6) {
#pragma unroll
                    for (int ai = 0; ai < 2; ++ai)
#pragma unroll
                        for (int m = 0; m < 4; ++m) { const float r = rst[ai * HALF + wr * 64 + m * 16 + fr];
#pragma unroll
                            for (int bj = 0; bj < 2; ++bj)
#pragma unroll
                                for (int n = 0; n < 2; ++n) acc[ai][bj][m][n] *= r; } }
            }
            const char* a1 = cA + (size_t)(t + 1) * kstep;
            const char* a2 = last ? nA : cA + (size_t)(t + 2) * kstep; const char* b2 = last ? nB : cB + (size_t)(t + 2) * kstep;
            const char* a3 = a2 + kstep; const char* b3 = b2 + kstep;
            if (last && has_next) S.a_ready(nxt);
            if constexpr (SP2) {
            PG8_LDB(B0, 0, 0); PG8_LDB(B1, 0, 1); PG8_SCHED; PG8_LDA(At, 0, 0); PG8_STAGE(PG8_SA(1, 1), a1 + hstep, voffA);
            PG8_WAIT_V(8); PG8_WAIT_L(0); PG8_BAR; PG8_MMA(0, 0, At, B0); PG8_MMA(0, 1, At, B1); PG8_BAR; PG8_SCHED;
            PG8_LDA(At, 0, 1); PG8_STAGE(PG8_SB(0, 0), b2, voffB); PG8_STAGE(PG8_SB(0, 1), b2 + hstep, voffB); PG8_STAGE(PG8_SA(0, 0), a2, voffA);
            PG8_WAIT_V(8); PG8_WAIT_L(0); PG8_BAR; PG8_MMA(1, 0, At, B0); PG8_MMA(1, 1, At, B1); PG8_BAR; PG8_SCHED;
            PG8_LDB(B0, 1, 0); PG8_LDB(B1, 1, 1); PG8_SCHED; PG8_LDA(At, 1, 0); PG8_STAGE(PG8_SA(0, 1), a2 + hstep, voffA);
            PG8_WAIT_V(8); PG8_WAIT_L(0); PG8_BAR; PG8_MMA(0, 0, At, B0); PG8_MMA(0, 1, At, B1); PG8_BAR; PG8_SCHED;
            PG8_LDA(At, 1, 1); PG8_STAGE(PG8_SB(1, 0), b3, voffB); PG8_STAGE(PG8_SB(1, 1), b3 + hstep, voffB); PG8_STAGE(PG8_SA(1, 0), a3, voffA);
            PG8_WAIT_V(8); PG8_WAIT_L(0); PG8_BAR; PG8_MMA(1, 0, At, B0); PG8_MMA(1, 1, At, B1); PG8_BAR; PG8_SCHED;
            } else {
            PG8_LDB(B0, 0, 0); PG8_SCHED; PG8_LDA(At, 0, 0); PG8_STAGE(PG8_SA(1, 1), a1 + hstep, voffA);
            PG8_WAIT_L(8); PG8_BAR; PG8_WAIT_L(0); PG8_MMA(0, 0, At, B0); PG8_BAR; PG8_SCHED;
            PG8_LDB(B1, 0, 1); PG8_STAGE(PG8_SB(0, 0), b2, voffB);
            PG8_BAR; PG8_WAIT_L(0); PG8_MMA(0, 1, At, B1); PG8_BAR;
            PG8_LDA(At, 0, 1); PG8_STAGE(PG8_SA(0, 0), a2, voffA);
            PG8_BAR; PG8_WAIT_L(0); PG8_MMA(1, 0, At, B0); PG8_BAR; PG8_SCHED;
            PG8_STAGE(PG8_SB(0, 1), b2 + hstep, voffB);
            PG8_WAIT_V(6); PG8_BAR; PG8_MMA(1, 1, At, B1); PG8_BAR;
            PG8_LDB(B0, 1, 0); PG8_SCHED; PG8_LDA(At, 1, 0); PG8_STAGE(PG8_SA(0, 1), a2 + hstep, voffA);
            PG8_WAIT_L(8); PG8_BAR; PG8_WAIT_L(0); PG8_MMA(0, 0, At, B0); PG8_BAR; PG8_SCHED;
            PG8_LDB(B1, 1, 1); PG8_STAGE(PG8_SB(1, 0), b3, voffB);
            PG8_BAR; PG8_WAIT_L(0); PG8_MMA(0, 1, At, B1); PG8_BAR;
            PG8_LDA(At, 1, 1); PG8_STAGE(PG8_SA(1, 0), a3, voffA);
            PG8_BAR; PG8_WAIT_L(0); PG8_MMA(1, 0, At, B0); PG8_BAR; PG8_SCHED;
            PG8_STAGE(PG8_SB(1, 1), b3 + hstep, voffB);
            PG8_WAIT_V(6); PG8_BAR; PG8_MMA(1, 1, At, B1); PG8_BAR;
            }
        }
        if constexpr (ALIGN_EPI) { if (wr == 0) PG8_BAR; }
        if constexpr (!Epi::AFTER_DRAIN) { E(acc, cur, wr, wc, fr, fq); S.done(cur); }
        if (!has_next) break;
#pragma unroll
        for (int a = 0; a < 2; ++a)
#pragma unroll
            for (int b = 0; b < 2; ++b)
#pragma unroll
                for (int m = 0; m < 4; ++m)
#pragma unroll
                    for (int n = 0; n < 2; ++n) acc[a][b][m][n] = (f32x4){0.f, 0.f, 0.f, 0.f};
        cur = nxt; cA = nA; cB = nB; ++ui;
        if constexpr (ALIGN_EPI) { if (wr == 1) PG8_BAR; }
    }
    PG8_WAIT_V(0);
    if constexpr (!ALIGN_EPI) { if (wr == 0) PG8_BAR; }
    PG8_BAR;
    if constexpr (Epi::AFTER_DRAIN) { E.fused(acc, cur, wr, wc, fr, fq, lds, wid, lane); S.done(cur); }
#undef PG8_SA
#undef PG8_SB
#undef PG8_STAGE
#undef PG8_LDA
#undef PG8_LDB
#undef PG8_MMA
#undef PG8_WAIT_V
#undef PG8_WAIT_L
#undef PG8_BAR
#undef PG8_SCHED
}
}
#include <hip/hip_bf16.h>
#include <cmath>
namespace attn_body {
using bf16=__hip_bfloat16;
using bf16x8=__attribute__((ext_vector_type(8)))short;
using s16x4=__attribute__((ext_vector_type(4)))short;
using f32x16=__attribute__((ext_vector_type(16)))float;
using u32x4=__attribute__((ext_vector_type(4)))unsigned;
using f32x4v=__attribute__((ext_vector_type(4)))float;
constexpr int BATCH=8,NHEAD=6,SEQ=8192,D=64,DM=NHEAD*D,ODM=1024;
constexpr int NW=8,QBLK=32,QB=QBLK*NW,KVBLK=64,NQB=SEQ/QB;
constexpr int ATTN_PITCH=DM, ATTN_UNIT_ROWS=QB;
__device__ __forceinline__ int crow(int r,int hi){return (r&3)+8*(r>>2)+4*hi;}
#define SBAR() __builtin_amdgcn_sched_barrier(0)
__device__ __forceinline__ void cmask(f32x16&p0,f32x16&p1,int jb,int qrel,int hi){
  const float NEG=-INFINITY; int kb=64*jb+4*hi;
  #pragma unroll
  for(int r=0;r<16;++r){int kv=kb+(r&3)+8*(r>>2); if(kv>qrel)p0[r]=NEG; if(kv+32>qrel)p1[r]=NEG;}
}

constexpr int NSLOT=3, SLOTB=8192;
constexpr int LDS_K=0, LDS_V=NSLOT*SLOTB, LDS_WS=2*NSLOT*SLOTB, LDS_OST=LDS_WS+NW*64*4, LDS_CT=LDS_OST+NW*4096, LDS_BYTES=LDS_CT+SEQ*4;
constexpr float C2=0.125f*1.4426950408889634f;
__device__ __forceinline__ void glds16(const void*gsrc,unsigned lds_dst){unsigned keep;
  asm volatile("s_mov_b32 %0, m0\n\ts_mov_b32 m0, %2\n\ts_nop 0\n\tglobal_load_lds_dwordx4 %1, off\n\ts_mov_b32 m0, %0":"=&s"(keep):"v"(gsrc),"s"(lds_dst):"memory");}
__device__ __forceinline__ float max3f(float a,float b,float c){float r;asm("v_max3_f32 %0, %1, %2, %3":"=v"(r):"v"(a),"v"(b),"v"(c));return r;}
__device__ __forceinline__ float max2f(float a,float b){float r;asm("v_max_f32_e32 %0, %1, %2":"=v"(r):"v"(a),"v"(b));return r;}
__device__ __forceinline__ float fadd_s(float a,float b){float r;asm("v_add_f32_e32 %0, %1, %2":"=v"(r):"v"(a),"v"(b));return r;}
__device__ __forceinline__ float fsub_s(float a,float b){float r;asm("v_sub_f32_e32 %0, %1, %2":"=v"(r):"v"(a),"v"(b));return r;}
typedef float f32x2_t __attribute__((ext_vector_type(2))); typedef __bf16 bf16x2_t __attribute__((ext_vector_type(2)));
__device__ __forceinline__ unsigned cvtpk_s(float lo,float hi){f32x2_t v={lo,hi};bf16x2_t b=__builtin_convertvector(v,bf16x2_t);return __builtin_bit_cast(unsigned,b);}
#define WAIT_BAR(N) asm volatile("s_waitcnt vmcnt(" #N ") lgkmcnt(0)\n\ts_barrier":::"memory")

__device__ __forceinline__ void qkt(f32x16&p0,f32x16&p1,const char*Kslot,const bf16x8*qr,int r32,int hi){
  const char*kb=Kslot+hi*1024+r32*16;
  #pragma unroll
  for(int d0=0;d0<4;++d0){
    const bf16x8 b0=*reinterpret_cast<const bf16x8*>(kb+d0*2048);
    const bf16x8 b1=*reinterpret_cast<const bf16x8*>(kb+d0*2048+512);
    {p0=__builtin_amdgcn_mfma_f32_32x32x16_bf16(b0,qr[d0],p0,0,0,0);p1=__builtin_amdgcn_mfma_f32_32x32x16_bf16(b1,qr[d0],p1,0,0,0);}}
}
typedef __attribute__((address_space(3))) const char* lds_cptr;
typedef short v4i16_t __attribute__((ext_vector_type(4)));
__device__ __forceinline__ void kload8(bf16x8*kf,lds_cptr kp){
  kf[0]=*(const __attribute__((address_space(3))) bf16x8*)(kp);      kf[1]=*(const __attribute__((address_space(3))) bf16x8*)(kp+512);
  kf[2]=*(const __attribute__((address_space(3))) bf16x8*)(kp+2048); kf[3]=*(const __attribute__((address_space(3))) bf16x8*)(kp+2560);
  kf[4]=*(const __attribute__((address_space(3))) bf16x8*)(kp+4096); kf[5]=*(const __attribute__((address_space(3))) bf16x8*)(kp+4608);
  kf[6]=*(const __attribute__((address_space(3))) bf16x8*)(kp+6144); kf[7]=*(const __attribute__((address_space(3))) bf16x8*)(kp+6656);
}
__device__ __forceinline__ void kload2(bf16x8*kf,lds_cptr kp,int j){ kf[2*j]=*(const __attribute__((address_space(3))) bf16x8*)(kp+j*2048); kf[2*j+1]=*(const __attribute__((address_space(3))) bf16x8*)(kp+j*2048+512); }
__device__ __forceinline__ s16x4 vtr(lds_cptr p){ return __builtin_bit_cast(s16x4,__builtin_amdgcn_ds_read_tr16_b64_v4i16((__attribute__((address_space(3))) v4i16_t*)p)); }
__device__ __forceinline__ float rowmax(const f32x16&p0,const f32x16&p1){
  float a=max3f(p0[0],p0[1],p1[0]),b=max3f(p0[2],p0[3],p1[1]);a=max3f(a,p1[2],p1[3]);
  #pragma unroll
  for(int r=4;r<16;r+=4){a=max3f(a,p0[r],p0[r+1]);b=max3f(b,p0[r+2],p0[r+3]);a=max3f(a,p1[r],p1[r+1]);b=max3f(b,p1[r+2],p1[r+3]);}
  const float m=max2f(a,b);
  auto rr=__builtin_amdgcn_permlane32_swap(__float_as_uint(m),__float_as_uint(m),false,false);
  return max2f(__uint_as_float(rr[0]),__uint_as_float(rr[1]));
}
__device__ __forceinline__ void pv(f32x16*o,int vb,bf16x8 pa0,bf16x8 pa1,bf16x8 pa2,bf16x8 pa3){
  #pragma unroll
  for(int d0=0;d0<2;++d0){s16x4 lo[4],hi[4];
    #pragma unroll
    for(int ks=0;ks<4;++ks){
      asm volatile("ds_read_b64_tr_b16 %0,%1 offset:%c2":"=&v"(lo[ks]):"v"(vb),"i"(d0*4096+ks*1024):"memory");
      asm volatile("ds_read_b64_tr_b16 %0,%1 offset:%c2":"=&v"(hi[ks]):"v"(vb),"i"(d0*4096+ks*1024+512):"memory");}
    asm volatile("s_waitcnt lgkmcnt(0)":::"memory");SBAR();
    #define PK(k) (bf16x8){lo[k][0],lo[k][1],lo[k][2],lo[k][3],hi[k][0],hi[k][1],hi[k][2],hi[k][3]}
    o[d0]=__builtin_amdgcn_mfma_f32_32x32x16_bf16(pa0,PK(0),o[d0],0,0,0);
    o[d0]=__builtin_amdgcn_mfma_f32_32x32x16_bf16(pa1,PK(1),o[d0],0,0,0);
    o[d0]=__builtin_amdgcn_mfma_f32_32x32x16_bf16(pa2,PK(2),o[d0],0,0,0);
    o[d0]=__builtin_amdgcn_mfma_f32_32x32x16_bf16(pa3,PK(3),o[d0],0,0,0);
    #undef PK
  }
}

#ifndef ATTN_STORE16
#define ATTN_STORE16(p,v) (*(u32x4*)(p)=(v))
#endif
template<int THRL> __device__ __forceinline__ void attn_unit(int b,int h,int qb,const bf16*Q,const bf16*__restrict__ K,const bf16*__restrict__ V,bf16*O,const float*__restrict__ CLrow,char*shm,float*SSQ){
  int tid=threadIdx.x; asm volatile("":"+v"(tid)); const int lane=tid&63,r32=lane&31,hi=lane>>5; const int wid=__builtin_amdgcn_readfirstlane(tid>>6);
  const long rowbase=(long)b*SEQ; const int q0=qb*QB;
  const bf16*Qw=Q+(rowbase+q0+wid*QBLK)*DM+h*D;
  const bf16*Kh=K+rowbase*DM+h*D,*Vh=V+rowbase*DM+h*D;
  const unsigned lds0=(unsigned)(uintptr_t)shm;
  float*wsf=(float*)(shm+LDS_WS)+wid*64;
  const bf16*ksrc=Kh+(long)lane*DM+wid*8;
  const bf16*vsrc=Vh+(long)(16*(wid&3)+(lane>>2))*DM+(wid>>2)*32+(lane&3)*8;
  const unsigned kdst=lds0+LDS_K+wid*1024, vdst=lds0+LDS_V+wid*1024;
  #define DMA_K(t,slot) glds16(ksrc+(long)(t)*KVBLK*DM,(unsigned)__builtin_amdgcn_readfirstlane(kdst+(slot)))
  #define DMA_V(t,slot) glds16(vsrc+(long)(t)*KVBLK*DM,(unsigned)__builtin_amdgcn_readfirstlane(vdst+(slot)))
  const int vb0=(int)(lds0+LDS_V)+((lane>>4)&1)*32+(lane&3)*8+(4*hi+((lane&15)>>2))*64;
  const char*Kbase=shm+LDS_K; bf16x8 kf[8];
  const lds_cptr shm3=(lds_cptr)shm; const lds_cptr kp0=shm3+LDS_K+hi*1024+r32*16; const lds_cptr vp0=shm3+LDS_V+((lane>>4)&1)*32+(lane&3)*8+(4*hi+((lane&15)>>2))*64;
  const int NT=(q0+QB)/KVBLK;
  { float*ct=(float*)(shm+LDS_CT); const int nk4=(q0+QB)>>2;
    for(int i=tid;i<nk4;i+=NW*64){ *(f32x4v*)(ct+4*i)=*(const f32x4v*)(CLrow+4*i); } }
  float cql=CLrow[q0+wid*QBLK+r32];
  asm volatile("s_waitcnt vmcnt(0) lgkmcnt(0)\n\ts_barrier":::"memory"); asm volatile("":"+v"(cql));
  typedef __attribute__((address_space(3))) const float* lds_fptr; const lds_fptr ct3=(lds_fptr)(shm3+LDS_CT);
  DMA_K(0,0);DMA_V(0,0);DMA_K(1,SLOTB);
  bf16x8 qr[4];
  #pragma unroll
  for(int d0=0;d0<4;++d0)qr[d0]=*reinterpret_cast<const bf16x8*>(&Qw[(long)r32*DM+d0*16+hi*8]);
  float mhat=0.f,l_reg=0.f;f32x16 o[2];o[0]=f32x16{};o[1]=f32x16{};float base=cql;
  const int qrel=wid*QBLK+r32;
  #define CMASK(P0,P1,t) do{int jb_=(t)-(NT-4); if(jb_>=0)cmask(P0,P1,jb_,qrel,hi);}while(0)
  bool resc=false;
  #define START(P0,P1) do{ const float rm=rowmax(P0,P1); resc=false; \
    { const float dl=rm; mhat=fadd_s(mhat,dl); \
      _Pragma("unroll") for(int r=0;r<16;++r){P0[r]=fsub_s(P0[r],dl);P1[r]=fsub_s(P1[r],dl);} \
      base=cql-mhat; } \
    _Pragma("unroll") for(int r=0;r<16;++r)P0[r]=__builtin_amdgcn_exp2f(P0[r]); }while(0)
  #define RESC() do{ if(resc){ asm volatile("s_waitcnt lgkmcnt(0)":::"memory"); \
      _Pragma("unroll") for(int d_=0;d_<2;++d_) _Pragma("unroll") for(int r=0;r<16;++r)o[d_][r]*=wsf[crow(r,hi)]; } }while(0)
  f32x16 pA0,pA1,pB0,pB1;
  #define CINIT(C0,C1,t) do{ const lds_fptr cp_=ct3+64*(t)+4*hi; \
    _Pragma("unroll") for(int g_=0;g_<4;++g_){ const f32x4v a_=*(const __attribute__((address_space(3))) f32x4v*)(cp_+8*g_); const f32x4v b_=*(const __attribute__((address_space(3))) f32x4v*)(cp_+32+8*g_); \
      C0[4*g_]=base-a_[0];C0[4*g_+1]=base-a_[1];C0[4*g_+2]=base-a_[2];C0[4*g_+3]=base-a_[3]; \
      C1[4*g_]=base-b_[0];C1[4*g_+1]=base-b_[1];C1[4*g_+2]=base-b_[2];C1[4*g_+3]=base-b_[3]; } }while(0)
  int sl_prev=0,sl_cur=0,sl_next=SLOTB;
  #define ROT() do{sl_prev=sl_cur;sl_cur=sl_next;sl_next=(sl_next==(NSLOT-1)*SLOTB)?0:sl_next+SLOTB;}while(0)
  DMA_K(2,2*SLOTB);
  WAIT_BAR(3);
  CINIT(pA0,pA1,0); qkt(pA0,pA1,Kbase,qr,r32,hi);asm volatile("s_nop 15\n\ts_nop 7":"+v"(pA0),"+v"(pA1));CMASK(pA0,pA1,0);
  START(pA0,pA1);
  CINIT(pB0,pB1,1);
  _Pragma("unroll") for(int r=0;r<16;++r)pA1[r]=__builtin_amdgcn_exp2f(pA1[r]);
  WAIT_BAR(0);
  DMA_K(3,0);DMA_V(1,SLOTB);
  ROT();
  kload8(kf,kp0+sl_cur);
  WAIT_BAR(2);
  s16x4 vlo[8],vhi[8]; u32x4 pw0,pw1,pw2,pw3;
  #define PKW(P,B) cvtpk_s(P[B],P[B+1])
  #define PAF(k) __builtin_bit_cast(bf16x8,pw##k)
  #define VFR(i) (bf16x8){vlo[i][0],vlo[i][1],vlo[i][2],vlo[i][3],vhi[i][0],vhi[i][1],vhi[i][2],vhi[i][3]}
  #define PIN(x) asm volatile("":"+v"(x))
  #define MX3(a,b,c) __builtin_fmaxf(__builtin_fmaxf((a),(b)),(c))
  #define GAPA(MF,A0,A1,A2,A3,W0,W1,PW) do{ MF; sacc+=A0; sacc+=A1; sacc+=A2; sacc+=A3; PIN(sacc); W0; W1; PIN(PW); SBAR(); }while(0)
  #define EX(v) __builtin_amdgcn_exp2f(v)
  #define CLOAD(P0,P1,t1) do{ const lds_fptr cp_=ct3+64*(t1)+4*hi; \
    _Pragma("unroll") for(int g_=0;g_<4;++g_){ const f32x4v a_=*(const __attribute__((address_space(3))) f32x4v*)(cp_+8*g_); const f32x4v b_=*(const __attribute__((address_space(3))) f32x4v*)(cp_+32+8*g_); \
      P0[4*g_]=a_[0];P0[4*g_+1]=a_[1];P0[4*g_+2]=a_[2];P0[4*g_+3]=a_[3]; P1[4*g_]=b_[0];P1[4*g_+1]=b_[1];P1[4*g_+2]=b_[2];P1[4*g_+3]=b_[3]; } }while(0)
  #define GAPB(MF,X,B,Y,YB) do{ MF; X[B]=EX(X[B]); X[B+1]=EX(X[B+1]); X[B+2]=EX(X[B+2]); X[B+3]=EX(X[B+3]); Y[YB]=base-Y[YB]; Y[YB+1]=base-Y[YB+1]; Y[YB+2]=base-Y[YB+2]; Y[YB+3]=base-Y[YB+3]; PIN(X); PIN(Y); SBAR(); }while(0)
  #define VRD(i) do{ vlo[i]=vtr(vp_+(((i)>>2)*4096+((i)&3)*1024)); vhi[i]=vtr(vp_+(((i)>>2)*4096+((i)&3)*1024+512)); }while(0)
  #define KRD(G,j) do{ if(G){ kload2(kf,kp0+sl_next,j); SBAR(); } }while(0)
  #define STEP(C0,C1,P0,P1,t,GK,GV,GL) do{ SBAR(); \
    const lds_cptr vp_=vp0+sl_prev; \
    VRD(0); SBAR(); float sacc=(P0[0]+P0[1]); \
    GAPA(C0=__builtin_amdgcn_mfma_f32_32x32x16_bf16(kf[0],qr[0],C0,0,0,0), P0[2],P0[3],P0[4],P0[5],     pw0[0]=PKW(P0,0), pw0[1]=PKW(P0,2), pw0); \
    VRD(4); SBAR(); GAPA(C1=__builtin_amdgcn_mfma_f32_32x32x16_bf16(kf[1],qr[0],C1,0,0,0), P0[6],P0[7],P0[8],P0[9],     pw0[2]=PKW(P0,4), pw0[3]=PKW(P0,6), pw0); \
    VRD(1); SBAR(); GAPA(C0=__builtin_amdgcn_mfma_f32_32x32x16_bf16(kf[2],qr[1],C0,0,0,0),   P0[10],P0[11],P0[12],P0[13], pw1[0]=PKW(P0,8), pw1[1]=PKW(P0,10), pw1); \
    VRD(5); SBAR(); GAPA(C1=__builtin_amdgcn_mfma_f32_32x32x16_bf16(kf[3],qr[1],C1,0,0,0),   P0[14],P0[15],P1[0],P1[1],   pw1[2]=PKW(P0,12),pw1[3]=PKW(P0,14), pw1); \
    VRD(2); SBAR(); GAPA(C0=__builtin_amdgcn_mfma_f32_32x32x16_bf16(kf[4],qr[2],C0,0,0,0),   P1[2],P1[3],P1[4],P1[5],     pw2[0]=PKW(P1,0), pw2[1]=PKW(P1,2), pw2); \
    VRD(6); SBAR(); GAPA(C1=__builtin_amdgcn_mfma_f32_32x32x16_bf16(kf[5],qr[2],C1,0,0,0),   P1[6],P1[7],P1[8],P1[9],     pw2[2]=PKW(P1,4), pw2[3]=PKW(P1,6), pw2); \
    VRD(3); SBAR(); GAPA(C0=__builtin_amdgcn_mfma_f32_32x32x16_bf16(kf[6],qr[3],C0,0,0,0),   P1[10],P1[11],P1[12],P1[13], pw3[0]=PKW(P1,8), pw3[1]=PKW(P1,10), pw3); \
    VRD(7); SBAR(); GAPA(C1=__builtin_amdgcn_mfma_f32_32x32x16_bf16(kf[7],qr[3],C1,0,0,0),   P1[14],P1[15],0.f,0.f,       pw3[2]=PKW(P1,12),pw3[3]=PKW(P1,14), pw3); \
    l_reg+=sacc; \
    CLOAD(P0,P1,(t)+1); \
    if(GK){DMA_K((t)+3,sl_cur);} if(GV){DMA_V((t)+1,sl_next);} \
    CMASK(C0,C1,t); \
    { float a=MX3(C0[0],C0[1],C1[0]),b=MX3(C0[2],C0[3],C1[1]); a=MX3(a,C1[2],C1[3]); \
      _Pragma("unroll") for(int r=4;r<16;r+=4){a=MX3(a,C0[r],C0[r+1]);b=MX3(b,C0[r+2],C0[r+3]);a=MX3(a,C1[r],C1[r+1]);b=MX3(b,C1[r+2],C1[r+3]);} \
      float rm=__builtin_fmaxf(a,b); { auto rr=__builtin_amdgcn_permlane32_swap(__float_as_uint(rm),__float_as_uint(rm),false,false); rm=__builtin_fmaxf(__uint_as_float(rr[0]),__uint_as_float(rr[1])); } \
      resc=false; \
      if(__builtin_expect(__any(rm>(float)THRL),0)){ const float dl=__builtin_fmaxf(rm,0.f); mhat+=dl; \
        _Pragma("unroll") for(int r=0;r<16;++r){C0[r]-=dl;C1[r]-=dl;} \
        base=cql-mhat; \
        const float f=__builtin_amdgcn_exp2f(-dl); l_reg*=f; if(hi==0)wsf[r32]=f; resc=true; } } \
    SBAR(); \
    GAPB(o[0]=__builtin_amdgcn_mfma_f32_32x32x16_bf16(PAF(0),VFR(0),o[0],0,0,0), C0,0, P0,0); \
    GAPB(o[1]=__builtin_amdgcn_mfma_f32_32x32x16_bf16(PAF(0),VFR(4),o[1],0,0,0), C0,4, P0,4); \
    KRD(GL,0); GAPB(o[0]=__builtin_amdgcn_mfma_f32_32x32x16_bf16(PAF(1),VFR(1),o[0],0,0,0), C0,8, P0,8); \
    KRD(GL,1); GAPB(o[1]=__builtin_amdgcn_mfma_f32_32x32x16_bf16(PAF(1),VFR(5),o[1],0,0,0), C0,12, P0,12); \
    KRD(GL,2); GAPB(o[0]=__builtin_amdgcn_mfma_f32_32x32x16_bf16(PAF(2),VFR(2),o[0],0,0,0), C1,0, P1,0); \
    KRD(GL,3); GAPB(o[1]=__builtin_amdgcn_mfma_f32_32x32x16_bf16(PAF(2),VFR(6),o[1],0,0,0), C1,4, P1,4); \
    GAPB(o[0]=__builtin_amdgcn_mfma_f32_32x32x16_bf16(PAF(3),VFR(3),o[0],0,0,0), C1,8, P1,8); \
    GAPB(o[1]=__builtin_amdgcn_mfma_f32_32x32x16_bf16(PAF(3),VFR(7),o[1],0,0,0), C1,12, P1,12); \
    }while(0)
  int t=1;
  #undef CMASK
  #define CMASK(P0,P1,t) do{}while(0)
  for(;t+5<NT;t+=2){
    STEP(pB0,pB1,pA0,pA1,t,true,true,true);     WAIT_BAR(2); RESC(); ROT();
    STEP(pA0,pA1,pB0,pB1,t+1,true,true,true);   WAIT_BAR(2); RESC(); ROT();
  }
  #undef CMASK
  #define CMASK(P0,P1,t) do{int jb_=(t)-(NT-4); if(jb_>=0)cmask(P0,P1,jb_,qrel,hi);}while(0)
  #define ENDW(tt) do{ if((tt)+3<NT){WAIT_BAR(2);} else if((tt)+2<NT){WAIT_BAR(1);} else {WAIT_BAR(0);} }while(0)
  for(;t+1<NT;t+=2){
    STEP(pB0,pB1,pA0,pA1,t,(t+3<NT),(t+1<NT),(t+1<NT));       ENDW(t);   RESC(); ROT();
    STEP(pA0,pA1,pB0,pB1,t+1,(t+4<NT),(t+2<NT),(t+2<NT));     ENDW(t+1); RESC(); ROT();
  }
  STEP(pB0,pB1,pA0,pA1,NT-1,false,false,false); RESC();
  { float sacc=pB0[0]+pB0[1]; _Pragma("unroll") for(int r=2;r<16;++r)sacc+=pB0[r]; _Pragma("unroll") for(int r=0;r<16;++r)sacc+=pB1[r]; l_reg+=sacc;
    pw0=(u32x4){PKW(pB0,0),PKW(pB0,2),PKW(pB0,4),PKW(pB0,6)};pw1=(u32x4){PKW(pB0,8),PKW(pB0,10),PKW(pB0,12),PKW(pB0,14)};pw2=(u32x4){PKW(pB1,0),PKW(pB1,2),PKW(pB1,4),PKW(pB1,6)};pw3=(u32x4){PKW(pB1,8),PKW(pB1,10),PKW(pB1,12),PKW(pB1,14)};
    SBAR(); pv(o,vb0+sl_cur,PAF(0),PAF(1),PAF(2),PAF(3)); }
  #undef PKW
  #undef PAF
  #undef VFR
  #undef PIN
  #undef MX3
  #undef GAPA
  #undef GAPB
  #undef CLOAD
  #undef EX
  #undef VRD
  #undef KRD
  #undef STEP
  #undef ENDW
  {auto rr=__builtin_amdgcn_permlane32_swap(__float_as_uint(l_reg),__float_as_uint(l_reg),false,false);l_reg=__uint_as_float(rr[0])+__uint_as_float(rr[1]);}
  if(hi==0)wsf[32+r32]=l_reg;asm volatile("s_waitcnt lgkmcnt(0)":::"memory");
  float rli[16];
  #pragma unroll
  for(int r=0;r<16;++r)rli[r]=__builtin_amdgcn_rcpf(wsf[32+crow(r,hi)]);
  bf16*Ow=O+(rowbase+q0+wid*QBLK)*ODM+h*D;
  { bf16*stg=(bf16*)(shm+LDS_OST)+wid*2048;
    #pragma unroll
    for(int r=0;r<16;++r){const int orow=crow(r,hi);
      #pragma unroll
      for(int d0=0;d0<2;++d0)stg[orow*64+d0*32+r32]=__float2bfloat16(o[d0][r]*rli[r]);}
    asm volatile("s_waitcnt lgkmcnt(0)":::"memory");
    #pragma unroll
    for(int i=0;i<4;++i){const int row=i*8+(lane>>3),ch=lane&7; const u32x4 v=*(const u32x4*)(stg+row*64+ch*8); ATTN_STORE16(Ow+(long)row*ODM+ch*8,v);
      float sq=0.f;
      #pragma unroll
      for(int e=0;e<4;++e){const float lo=__uint_as_float(v[e]<<16),hi2=__uint_as_float(v[e]&0xffff0000u);sq+=lo*lo+hi2*hi2;}
      sq+=__shfl_xor(sq,1);sq+=__shfl_xor(sq,2);sq+=__shfl_xor(sq,4);
      if(ch==0)SSQ[(rowbase+q0+wid*QBLK+row)*8+h]=sq;} }
  asm volatile("s_waitcnt lgkmcnt(0)\n\ts_barrier":::"memory");
  #undef DMA_K
  #undef DMA_V
  #undef CMASK
  #undef START
  #undef CINIT
  #undef RESC
  #undef ROT
}
constexpr int ATTN_LDS_BYTES=LDS_BYTES;
#undef SBAR
#undef WAIT_BAR
}
constexpr int D = 1024, NB = 8, SEQ = 8192, MP = NB * SEQ, DB = 32, DS = 16, MS = DB * DS, M = MP + MS; static_assert(M == pg8::SM_ROWS, "gate matrix rows");
constexpr int NHA = 6, NHB = 6, HD = 64, WA = 384, WB = 384, WC = 256, DFF = 2816, DIN = 3218, NIN = 3328, NF1 = 2 * DFF, PAST = 4096, NCH = SEQ / 64;
constexpr float LOG2E = 1.4426950408889634f, QSCALE = 0.125f * LOG2E;
constexpr int NWAVES = 8;
constexpr size_t O_YP = 0, O_YS = O_YP + (size_t)MP * D, O_KP = O_YS + (size_t)MS * D, O_VP = O_KP + 2ull * MP * WA, O_LFP = O_VP + 2ull * MP * WA, O_CVP = O_LFP + 2ull * MP * NHA,
                 O_SP = O_CVP + 2ull * NB * 3 * 1152, O_KS = O_SP + 2ull * NB * NHB * 4096, O_VS = O_KS + 2ull * MS * WA, O_LFS = O_VS + 2ull * MS * WA, O_CVS = O_LFS + 2ull * MS * NHA,
                 O_SS = O_CVS + 2ull * DB * 3 * 1152, O_CS = O_SS + 2ull * DB * NHB * 4096, O_END = O_CS + 2ull * MS * WC;
constexpr size_t MiB = 1u << 20;
constexpr size_t WS_CTL = 0, CTL_ZERO_BYTES = 1 * MiB;
constexpr size_t WS_WIN = 2 * MiB, WS_WOUT = 16 * MiB, WS_WF1 = 20 * MiB, WS_WF2 = 42 * MiB, WS_WSG = 53 * MiB, WS_SM = 54 * MiB, WS_CL = 63 * MiB, WS_GL = 65 * MiB;
constexpr size_t WS_H = 66 * MiB, WS_Q = 195 * MiB, WS_K = 244 * MiB, WS_V = 293 * MiB, WS_BQKV = 342 * MiB, WS_BZ = 488 * MiB, WS_CU = 537 * MiB, WS_CV = 570 * MiB;
constexpr size_t WS_ACT = WS_Q;
constexpr size_t WS_PREP = 603 * MiB;
constexpr size_t WS_M1 = WS_PREP;
constexpr size_t WS_CAT = 843 * MiB;
constexpr size_t WS_M2 = WS_CAT;
constexpr size_t WS_XR = 972 * MiB;
constexpr size_t WS_PART = 1101 * MiB;
constexpr size_t WS_SSQ = 1105 * MiB;
constexpr size_t WS_END = 1108 * MiB;
static_assert(WS_WIN + 2ull * NIN * D * 2 <= WS_WOUT && WS_WOUT + 2ull * D * D * 2 <= WS_WF1 && WS_WF1 + 2ull * NF1 * D * 2 <= WS_WF2 && WS_WF2 + 2ull * D * DFF * 2 <= WS_WSG && WS_WSG + 2ull * 4 * 128 * 128 * 2 <= WS_SM, "ws map 1");
static_assert(WS_SM + (size_t)M * 32 * 4 <= WS_CL && WS_CL + 48ull * SEQ * 4 <= WS_GL && WS_GL + 6144 * 4 <= WS_H && WS_H + (size_t)M * D * 2 <= WS_Q && WS_Q + (size_t)M * WA * 2 <= WS_K && WS_K + (size_t)M * WA * 2 <= WS_V, "ws map 2");
static_assert(WS_V + (size_t)M * WA * 2 <= WS_BQKV && WS_BQKV + (size_t)M * 1152 * 2 <= WS_BZ && WS_BZ + (size_t)M * WB * 2 <= WS_CU && WS_CU + (size_t)M * WC * 2 <= WS_CV && WS_CV + (size_t)M * WC * 2 <= WS_PREP, "ws map 3");
static_assert(WS_ACT + (size_t)M * DFF * 2 <= WS_PREP && WS_PREP + 6144ull * 40960 <= WS_CAT && WS_M1 + (size_t)M * D * 2 <= WS_CAT && WS_CAT + (size_t)M * D * 2 <= WS_XR && WS_XR + (size_t)M * D * 2 <= WS_END, "ws map 4");
constexpr int CW_BAR = 4096;
constexpr int CW_QUEUE = 81920;
constexpr int N_PHASES = 19;
constexpr int LDS_BYTES = 159744;
constexpr int MISC_OFF = 155648;
constexpr int PREP_WAVE_LDS = 19456;

#define DI __device__ __forceinline__
#define GAS __attribute__((address_space(1)))
#define LAS __attribute__((address_space(3)))
typedef unsigned short bf16;
typedef unsigned v4u __attribute__((ext_vector_type(4)));
typedef unsigned v2u __attribute__((ext_vector_type(2)));
typedef float f32x4 __attribute__((ext_vector_type(4)));
typedef short bf16x8 __attribute__((ext_vector_type(8)));
#define RLX_AGENT __ATOMIC_RELAXED, __HIP_MEMORY_SCOPE_AGENT
#define LDS_WAIT() asm volatile("s_waitcnt lgkmcnt(0)" ::: "memory")
#define VM_WAIT() asm volatile("s_waitcnt vmcnt(0)" ::: "memory")
#define MFMA16(a, b, c) __builtin_amdgcn_mfma_f32_16x16x32_bf16((a), (b), (c), 0, 0, 0)
typedef float f32x2c __attribute__((ext_vector_type(2))); typedef __bf16 bf16x2c __attribute__((ext_vector_type(2)));
DI unsigned pk2(float lo, float hi) { const f32x2c v = {lo, hi}; const bf16x2c b = __builtin_convertvector(v, bf16x2c); return __builtin_bit_cast(unsigned, b); }
DI bf16 f2bf(float x) { return (bf16)(pk2(x, 0.f) & 0xffffu); }
DI float bf2f(bf16 h) { return __builtin_bit_cast(float, (unsigned)h << 16); }
DI float bflo(unsigned w) { return __builtin_bit_cast(float, w << 16); }
DI float bfhi(unsigned w) { return __builtin_bit_cast(float, w & 0xffff0000u); }
DI float wave_sum(float v) {
#pragma unroll
    for (int o = 1; o < 64; o <<= 1) v += __shfl_xor(v, o);
    return v; }
DI float wave_max(float v) {
#pragma unroll
    for (int o = 1; o < 64; o <<= 1) v = fmaxf(v, __shfl_xor(v, o));
    return v; }
DI float wave_incl_scan(float v, int lane) {
#pragma unroll
    for (int o = 1; o < 64; o <<= 1) { const float t = __shfl_up(v, o); if (lane >= o) v += t; }
    return v; }
DI bf16x8 pack8(const f32x4 a, const f32x4 b) { v4u p; p.x = pk2(a[0], a[1]); p.y = pk2(a[2], a[3]); p.z = pk2(b[0], b[1]); p.w = pk2(b[2], b[3]); return __builtin_bit_cast(bf16x8, p); }
DI int pinv(int t) { return 32 * (t >> 5) + 8 * ((t >> 2) & 3) + 4 * ((t >> 4) & 1) + (t & 3); }
#define XB_TMO      128
#define XB_XCNT(j)  (256  + 64 * (j))
#define XB_XSUB(j)  (1280 + 64 * (j))
#define XB_XGEN(j)  (2304 + 64 * (j))
#define XB_TOP      3328
#define XB_TOPGEN   3392
#define XCD_BAR_WORDS 3456
#define XB_SPIN_CAP (1u << 18)

__device__ __forceinline__ unsigned xb_ld(unsigned* p)              { return __hip_atomic_load(p, __ATOMIC_RELAXED, __HIP_MEMORY_SCOPE_AGENT); }
__device__ __forceinline__ unsigned xb_add(unsigned* p, unsigned v) { return __hip_atomic_fetch_add(p, v, __ATOMIC_RELAXED, __HIP_MEMORY_SCOPE_AGENT); }
__device__ __forceinline__ unsigned xb_xcc_id() { return (unsigned)__builtin_amdgcn_s_getreg((3 << 11) | 20) & 0xFu; }
#define XB_SPIN(cond, bar) do { unsigned _sp = 0; while (cond) { __builtin_amdgcn_s_sleep(1); \
    if ((++_sp & 255u) == 0u) { if (xb_ld(&(bar)[XB_TMO])) break; if (_sp > XB_SPIN_CAP) { atomicAdd(&(bar)[XB_TMO], 1u); break; } } } } while (0)

struct XcdBarrier {
    unsigned* bar; unsigned x;
    volatile LAS unsigned* st;
};

__device__ __forceinline__ XcdBarrier xcd_barrier_post(unsigned* bar, volatile LAS unsigned* st) {
    XcdBarrier b; b.bar = bar; b.x = xb_xcc_id(); b.st = st;
    if (threadIdx.x == 0) (void)xb_add(&bar[XB_XCNT(b.x)], 1u);
    return b;
}
__device__ __forceinline__ void xcd_barrier_complete(unsigned* bar, unsigned x, unsigned& nloc, unsigned& nx) {
    const unsigned G = gridDim.x * gridDim.y * gridDim.z;
    unsigned sum, cnt, mine, sp = 0u;
    for (;;) {
        sum = 0u; cnt = 0u; mine = 0u;
#pragma unroll
        for (unsigned j = 0; j < 16; ++j) { const unsigned c = xb_ld(&bar[XB_XCNT(j)]); sum += c; cnt += (c > 0u) ? 1u : 0u; mine = (j == x) ? c : mine; }
        if (sum == G) break;
        __builtin_amdgcn_s_sleep(1);
        if ((++sp & 255u) == 0u) { if (xb_ld(&bar[XB_TMO])) break; if (sp > XB_SPIN_CAP) { atomicAdd(&bar[XB_TMO], 1u); break; } }
    }
    nloc = mine > 0u ? mine : 1u; nx = cnt > 0u ? cnt : 1u;
}

__device__ __forceinline__ void xcd_barrier(const XcdBarrier& b) {
    asm volatile("s_waitcnt vmcnt(0)" ::: "memory");
    __syncthreads();
    if (threadIdx.x == 0) {
        unsigned* bar = b.bar;
        __builtin_amdgcn_s_waitcnt(0);
        unsigned nloc = b.st[0], nx = b.st[1];
        if (nloc == 0u) { xcd_barrier_complete(bar, b.x, nloc, nx); b.st[0] = nloc; b.st[1] = nx; }
        const unsigned old = xb_add(&bar[XB_XSUB(b.x)], 1u);
        const unsigned gen = old / nloc;
        if (old + 1u == (gen + 1u) * nloc) {
            __builtin_amdgcn_fence(__ATOMIC_RELEASE, "agent");
            asm volatile("s_waitcnt vmcnt(0)" ::: "memory");
            const unsigned og = xb_add(&bar[XB_TOP], 1u);
            const unsigned tg = og / nx;
            if (og + 1u == (tg + 1u) * nx) xb_add(&bar[XB_TOPGEN], 1u);
            else XB_SPIN(xb_ld(&bar[XB_TOPGEN]) == tg, bar);
            __builtin_amdgcn_fence(__ATOMIC_ACQUIRE, "agent");
            xb_add(&bar[XB_XGEN(b.x)], 1u);
            asm volatile("s_waitcnt vmcnt(0)" ::: "memory");
        } else {
            XB_SPIN(xb_ld(&bar[XB_XGEN(b.x)]) == gen, bar);
            __builtin_amdgcn_fence(__ATOMIC_ACQUIRE, "agent");
            asm volatile("s_waitcnt vmcnt(0)" ::: "memory");
        }
    }
    __syncthreads();
}
DI int colmap_in(int n) {
    const int hh = n >> 7, c = n & 127;
    if (hh < 9) return hh * 128 + c;
    if (hh < 18) return 1158 + (hh - 9) * 128 + c;
    if (hh < 21) return 2322 + (hh - 18) * 128 + c;
    if (hh < 23) return 2706 + (hh - 21) * 128 + c;
    if (hh < 25) return 2962 + (hh - 23) * 128 + c;
    if (c < 6) return 1152 + c;
    if (c < 12) return 2310 + (c - 6);
    if (c < 18) return 2316 + (c - 12);
    return -1;
}
DI int colmap_f1(int n) { const int pn = n >> 8, bj = (n >> 7) & 1, c = n & 127; return bj * DFF + pn * 128 + c; }
template <int MAP> DI void p0_transpose_item(const float* W, int K, int N, int nblk, bf16* WT, LAS float* scr, int item, int lane, const float* kscale = nullptr, int kscale_n = 0) {
    const int kb = item / nblk, nb = item % nblk, k0 = 64 * kb, n0 = 32 * nb;
    const int nn = n0 + (lane & 31); const int sc = MAP == 1 ? colmap_in(nn) : MAP == 2 ? colmap_f1(nn) : nn;
#pragma unroll 8
    for (int i = 0; i < 32; ++i) { const int kk = 2 * i + (lane >> 5); float wv = sc >= 0 ? W[(size_t)(k0 + kk) * N + sc] : 0.f; if (kscale && k0 < kscale_n) wv *= kscale[k0 + kk]; scr[kk * 33 + (lane & 31)] = wv; }
    LDS_WAIT(); asm volatile("" ::: "memory");
    const int c = lane & 7;
#pragma unroll
    for (int j = 0; j < 4; ++j) { const int n = (lane >> 3) + 8 * j; const LAS float* s = scr + (8 * c) * 33 + n;
        v4u o; o.x = pk2(s[0 * 33], s[1 * 33]); o.y = pk2(s[2 * 33], s[3 * 33]); o.z = pk2(s[4 * 33], s[5 * 33]); o.w = pk2(s[6 * 33], s[7 * 33]);
        *(v4u*)(WT + (size_t)(n0 + n) * K + k0 + 8 * c) = o; }
    LDS_WAIT(); asm volatile("" ::: "memory");
}
template <int R, class XIN> DI void rms_rows_to_bf16(int m0, int stride, int mend, XIN xin_of, const float* g, bf16* Hb, int lane) {
    f32x4 v[R][4];
#pragma unroll
    for (int r = 0; r < R; ++r) { const int m = min(m0 + r * stride, mend - 1); const f32x4* xr = (const f32x4*)xin_of(m) + lane;
#pragma unroll
        for (int j = 0; j < 4; ++j) v[r][j] = xr[64 * j]; }
    f32x4 gg[4];
#pragma unroll
    for (int j = 0; j < 4; ++j) gg[j] = ((const f32x4*)g + lane)[64 * j];
#pragma unroll
    for (int r = 0; r < R; ++r) { const int m = m0 + r * stride; if (m < mend) { float s = 0.f;
#pragma unroll
        for (int j = 0; j < 4; ++j) s += (v[r][j].x * v[r][j].x + v[r][j].y * v[r][j].y) + (v[r][j].z * v[r][j].z + v[r][j].w * v[r][j].w);
        const float rs = 1.0f / sqrtf(wave_sum(s) * (1.f / D) + 1e-6f);
        v2u* o8 = (v2u*)(Hb + (size_t)m * D) + lane;
#pragma unroll
        for (int j = 0; j < 4; ++j) { v2u w; w.x = pk2(v[r][j].x * rs * gg[j].x, v[r][j].y * rs * gg[j].y); w.y = pk2(v[r][j].z * rs * gg[j].z, v[r][j].w * rs * gg[j].w); o8[64 * j] = w; } } }
}
struct RowsF32Split { const float* p; const float* s; __device__ __forceinline__ const float* operator()(int m) const { return m < MP ? p + (size_t)m * D : s + (size_t)(m - MP) * D; } };
struct PairF32 { const float* p0; const float* p1; };
template <class T> struct IsPair { static constexpr bool v = false; }; template <> struct IsPair<PairF32> { static constexpr bool v = true; };
struct RowsBf16 { bf16* b; __device__ __forceinline__ bf16* operator()(int m) const { return b + (size_t)m * D; } };
template <bool XF32, bool OF32, int R, class MSRC, class XIN, class XOUT> DI void norm_res_rows(int m0, int stride, int mend, MSRC Mb, XIN xin_of, XOUT xout_of, const float* g1, const float* gn, bf16* Hb, int lane) {
    constexpr bool PAIR = IsPair<MSRC>::v;
    v4u mw[R][2]; f32x4 xf[R][2][2]; v4u xb[R][2]; f32x4 pa[R][2][2], pb[R][2][2];
#pragma unroll
    for (int r = 0; r < R; ++r) { const int m = min(m0 + r * stride, mend - 1);
#pragma unroll
        for (int j = 0; j < 2; ++j) {
            if constexpr (PAIR) { const float* a = Mb.p0 + (size_t)(m - MP) * D + 512 * j; const float* b = Mb.p1 + (size_t)(m - MP) * D + 512 * j;
                pa[r][j][0] = *((const f32x4*)a + 2 * lane); pa[r][j][1] = *((const f32x4*)a + 2 * lane + 1); pb[r][j][0] = *((const f32x4*)b + 2 * lane); pb[r][j][1] = *((const f32x4*)b + 2 * lane + 1); }
            else mw[r][j] = *((const v4u*)(Mb + (size_t)m * D + 512 * j) + lane);
            if (XF32) { const float* xin = (const float*)xin_of(m); xf[r][j][0] = *((const f32x4*)(xin + 512 * j) + 2 * lane); xf[r][j][1] = *((const f32x4*)(xin + 512 * j) + 2 * lane + 1); }
            else xb[r][j] = *((const v4u*)((const bf16*)xin_of(m) + 512 * j) + lane); } }
    float gg1[16], ggn[16];
#pragma unroll
    for (int j = 0; j < 2; ++j) { const f32x4 ga = *((const f32x4*)(g1 + 512 * j) + 2 * lane), gb = *((const f32x4*)(g1 + 512 * j) + 2 * lane + 1);
        gg1[8 * j] = ga.x; gg1[8 * j + 1] = ga.y; gg1[8 * j + 2] = ga.z; gg1[8 * j + 3] = ga.w; gg1[8 * j + 4] = gb.x; gg1[8 * j + 5] = gb.y; gg1[8 * j + 6] = gb.z; gg1[8 * j + 7] = gb.w;
        if (gn) { const f32x4 na = *((const f32x4*)(gn + 512 * j) + 2 * lane), nb = *((const f32x4*)(gn + 512 * j) + 2 * lane + 1);
            ggn[8 * j] = na.x; ggn[8 * j + 1] = na.y; ggn[8 * j + 2] = na.z; ggn[8 * j + 3] = na.w; ggn[8 * j + 4] = nb.x; ggn[8 * j + 5] = nb.y; ggn[8 * j + 6] = nb.z; ggn[8 * j + 7] = nb.w; } }
#pragma unroll
    for (int r = 0; r < R; ++r) { const int m = m0 + r * stride; const bool live = m < mend; {
        float mv[16], xv[16]; float s = 0.f;
#pragma unroll
        for (int j = 0; j < 2; ++j) {
            if constexpr (PAIR) { const f32x4 a = pa[r][j][0] + pb[r][j][0], b = pa[r][j][1] + pb[r][j][1];
                mv[8 * j + 0] = a.x; mv[8 * j + 1] = a.y; mv[8 * j + 2] = a.z; mv[8 * j + 3] = a.w; mv[8 * j + 4] = b.x; mv[8 * j + 5] = b.y; mv[8 * j + 6] = b.z; mv[8 * j + 7] = b.w; }
            else { const v4u w = mw[r][j];
            mv[8 * j + 0] = bflo(w.x); mv[8 * j + 1] = bfhi(w.x); mv[8 * j + 2] = bflo(w.y); mv[8 * j + 3] = bfhi(w.y); mv[8 * j + 4] = bflo(w.z); mv[8 * j + 5] = bfhi(w.z); mv[8 * j + 6] = bflo(w.w); mv[8 * j + 7] = bfhi(w.w); }
            if (XF32) { const f32x4 a = xf[r][j][0], b = xf[r][j][1]; xv[8 * j + 0] = a.x; xv[8 * j + 1] = a.y; xv[8 * j + 2] = a.z; xv[8 * j + 3] = a.w; xv[8 * j + 4] = b.x; xv[8 * j + 5] = b.y; xv[8 * j + 6] = b.z; xv[8 * j + 7] = b.w; }
            else { const v4u x = xb[r][j]; xv[8 * j + 0] = bflo(x.x); xv[8 * j + 1] = bfhi(x.x); xv[8 * j + 2] = bflo(x.y); xv[8 * j + 3] = bfhi(x.y); xv[8 * j + 4] = bflo(x.z); xv[8 * j + 5] = bfhi(x.z); xv[8 * j + 6] = bflo(x.w); xv[8 * j + 7] = bfhi(x.w); } }
#pragma unroll
        for (int i = 0; i < 16; ++i) s += mv[i] * mv[i];
        const float rs = 1.0f / sqrtf(wave_sum(s) * (1.f / D) + 1e-6f);
        float s2 = 0.f;
#pragma unroll
        for (int j = 0; j < 2; ++j) {
#pragma unroll
            for (int e = 0; e < 8; ++e) { xv[8 * j + e] += mv[8 * j + e] * rs * gg1[8 * j + e]; s2 += xv[8 * j + e] * xv[8 * j + e]; }
            if (!live) continue;
            if (OF32) { float* xout = (float*)xout_of(m);
                *((f32x4*)(xout + 512 * j) + 2 * lane) = (f32x4){xv[8 * j], xv[8 * j + 1], xv[8 * j + 2], xv[8 * j + 3]};
                *((f32x4*)(xout + 512 * j) + 2 * lane + 1) = (f32x4){xv[8 * j + 4], xv[8 * j + 5], xv[8 * j + 6], xv[8 * j + 7]}; }
            else { v4u w; w.x = pk2(xv[8 * j], xv[8 * j + 1]); w.y = pk2(xv[8 * j + 2], xv[8 * j + 3]); w.z = pk2(xv[8 * j + 4], xv[8 * j + 5]); w.w = pk2(xv[8 * j + 6], xv[8 * j + 7]);
                *((v4u*)((bf16*)xout_of(m) + 512 * j) + lane) = w; } }
        if (gn && live) {
            const float rs2 = 1.0f / sqrtf(wave_sum(s2) * (1.f / D) + 1e-6f);
#pragma unroll
            for (int j = 0; j < 2; ++j) { v4u w; w.x = pk2(xv[8 * j] * rs2 * ggn[8 * j], xv[8 * j + 1] * rs2 * ggn[8 * j + 1]); w.y = pk2(xv[8 * j + 2] * rs2 * ggn[8 * j + 2], xv[8 * j + 3] * rs2 * ggn[8 * j + 3]);
                w.z = pk2(xv[8 * j + 4] * rs2 * ggn[8 * j + 4], xv[8 * j + 5] * rs2 * ggn[8 * j + 5]); w.w = pk2(xv[8 * j + 6] * rs2 * ggn[8 * j + 6], xv[8 * j + 7] * rs2 * ggn[8 * j + 7]);
                *((v4u*)(Hb + (size_t)m * D + 512 * j) + lane) = w; } }
    } }
}
DI float logsig_f(float y) { return fminf(y, 0.f) - log1pf(__expf(-fabsf(y))); }
DI float gdn_decay_f(float x, float a_log, float dt_bias) { return -__expf(a_log) * pg8::softplus_f(x + dt_bias); }
DI float sigmoid_f(float x) { return __builtin_amdgcn_rcpf(1.f + __expf(-x)); }
DI void cumsum_unit(int bh, const float* SM, const float* b_f, float* out_lf, float* CL, LAS unsigned char* lds, int tid, int lane, int wid) {
    asm volatile("" : "+v"(tid), "+v"(lane));
    const int b = bh / NHA, h = bh % NHA; LAS float* wt = (LAS float*)lds; LAS float* lfs = (LAS float*)(lds + 1024);
    float v[16]; float run = 0.f; const float bfh = b_f[h];
#pragma unroll
    for (int i = 0; i < 16; ++i) { const size_t row = (size_t)b * SEQ + tid * 16 + i; const float lf = logsig_f(SM[(size_t)h * M + row] + bfh); lfs[tid * 17 + i] = lf; run += lf; v[i] = run; }
    const float incl = wave_incl_scan(run, lane);
    if (lane == 63) wt[wid] = incl;
    LDS_WAIT(); __syncthreads();
#pragma unroll
    for (int i = 0; i < 16; ++i) { const int r = i * 512 + tid; out_lf[((size_t)b * SEQ + r) * NHA + h] = lfs[(r >> 4) * 17 + (r & 15)]; }
    float off = incl - run;
    for (int w = 0; w < wid; ++w) off += wt[w];
    float* dst = CL + (size_t)bh * SEQ + tid * 16;
#pragma unroll
    for (int i = 0; i < 4; ++i) *((f32x4*)dst + i) = (f32x4){(v[4 * i] + off) * LOG2E, (v[4 * i + 1] + off) * LOG2E, (v[4 * i + 2] + off) * LOG2E, (v[4 * i + 3] + off) * LOG2E};
    __syncthreads();
}
DI void sgate_unit(int u, const bf16* CU, const bf16* CV, const bf16* WSG, const float* g_cv, const float* b_cv, const float* b_s, const float* g_c_out, bf16* CAT, LAS unsigned char* lds, int tid, int lane, int wid) {
    asm volatile("" : "+v"(tid), "+v"(lane));
    const int row0 = u * 128; const int fr = lane & 15, fq = lane >> 4;
    LAS bf16* vnT = (LAS bf16*)lds;
    LAS float* part = (LAS float*)(lds + 256 * 272);
    LAS bf16* cus = (LAS bf16*)(lds + 73728);
#pragma unroll
    for (int p = 0; p < 8; ++p) { const int rr = 16 * wid + 2 * p;
        __builtin_amdgcn_global_load_lds((const unsigned*)(CU + (size_t)(row0 + rr) * WC + lane * 8), (LAS unsigned*)(lds + 73728 + rr * 512), 16, 0, 0); }
    const int g = wid >> 1, ih = wid & 1;
    bf16x8 wa[4][4];
#pragma unroll
    for (int ks = 0; ks < 4; ++ks)
#pragma unroll
        for (int mt = 0; mt < 4; ++mt) wa[ks][mt] = *(const bf16x8*)(WSG + (size_t)(g * 128 + 64 * ih + 16 * mt + fr) * 128 + 32 * ks + 8 * fq);
    { const int j = tid >> 2, qd = tid & 3; const bf16* src = CV + (size_t)(row0 + j) * WC + 8 * qd;
      float x[64]; float s1 = 0.f;
#pragma unroll
      for (int i = 0; i < 8; ++i) { const v4u w = *(const v4u*)(src + 32 * i); x[8 * i] = bflo(w.x); x[8 * i + 1] = bfhi(w.x); x[8 * i + 2] = bflo(w.y); x[8 * i + 3] = bfhi(w.y); x[8 * i + 4] = bflo(w.z); x[8 * i + 5] = bfhi(w.z); x[8 * i + 6] = bflo(w.w); x[8 * i + 7] = bfhi(w.w); }
#pragma unroll
      for (int i = 0; i < 64; ++i) s1 += x[i];
      s1 += __shfl_xor(s1, 1); s1 += __shfl_xor(s1, 2);
      const float mean = s1 * (1.f / 256.f); float s2 = 0.f;
#pragma unroll
      for (int i = 0; i < 64; ++i) { x[i] -= mean; s2 += x[i] * x[i]; }
      s2 += __shfl_xor(s2, 1); s2 += __shfl_xor(s2, 2);
      const float rstd = 1.0f / sqrtf(s2 * (1.f / 256.f) + 1e-5f);
#pragma unroll
      for (int i = 0; i < 64; ++i) { const int c = 32 * (i >> 3) + 8 * qd + (i & 7); vnT[c * 136 + j] = f2bf(x[i] * rstd * g_cv[c] + b_cv[c]); } }
    VM_WAIT(); LDS_WAIT(); __syncthreads();
    f32x4 acc[4][4];
#pragma unroll
    for (int mt = 0; mt < 4; ++mt)
#pragma unroll
        for (int nt = 0; nt < 4; ++nt) acc[mt][nt] = (f32x4){0.f, 0.f, 0.f, 0.f};
#pragma unroll
    for (int ks = 0; ks < 4; ++ks) { bf16x8 bb[4];
#pragma unroll
        for (int nt = 0; nt < 4; ++nt) bb[nt] = *(const LAS bf16x8*)(vnT + (64 * g + 16 * nt + fr) * 136 + 32 * ks + 8 * fq);
#pragma unroll
        for (int mt = 0; mt < 4; ++mt)
#pragma unroll
            for (int nt = 0; nt < 4; ++nt) acc[mt][nt] = MFMA16(wa[ks][mt], bb[nt], acc[mt][nt]); }
#pragma unroll
    for (int mt = 0; mt < 4; ++mt)
#pragma unroll
        for (int r = 0; r < 4; ++r) { const int i = 64 * ih + 16 * mt + 4 * fq + r; const float bs = b_s[g * 128 + i]; float ss = 0.f;
#pragma unroll
            for (int nt = 0; nt < 4; ++nt) { const int c = 64 * g + 16 * nt + fr; const float oc = bf2f(cus[i * 256 + c]) * (acc[mt][nt][r] + bs); acc[mt][nt][r] = oc; ss += oc * oc; }
            ss += __shfl_xor(ss, 1); ss += __shfl_xor(ss, 2); ss += __shfl_xor(ss, 4); ss += __shfl_xor(ss, 8);
            if (fr == 0) part[g * 128 + i] = ss; }
    LDS_WAIT(); __syncthreads();
#pragma unroll
    for (int mt = 0; mt < 4; ++mt)
#pragma unroll
        for (int r = 0; r < 4; ++r) { const int i = 64 * ih + 16 * mt + 4 * fq + r; const float rs = 1.0f / sqrtf((part[i] + part[128 + i] + part[256 + i] + part[384 + i]) * (1.f / 256.f) + 1e-6f);
#pragma unroll
            for (int nt = 0; nt < 4; ++nt) { const int c = 64 * g + 16 * nt + fr; cus[i * 256 + c] = f2bf(acc[mt][nt][r] * rs * g_c_out[c]); } }
    LDS_WAIT(); __syncthreads();
#pragma unroll
    for (int p = 0; p < 8; ++p) { const int rr = 16 * wid + 2 * p + (lane >> 5); *(v4u*)(CAT + (size_t)(row0 + rr) * D + 768 + (lane & 31) * 8) = *(const LAS v4u*)(cus + rr * 256 + (lane & 31) * 8); }
    LDS_WAIT(); __syncthreads();
}
DI void sgate_sample_unit(int b, const bf16* CU, const bf16* CV, const float* w_s, const float* g_cv, const float* b_cv, const float* b_s, const float* g_c_out, bf16* CAT, float* out_cv, LAS unsigned char* lds, int tid) {
    asm volatile("" : "+v"(tid));
    LAS float* vn = (LAS float*)lds;
    const int i = tid >> 5, p8 = (tid & 31) * 8; const int row = MP + b * DS + i;
    { const v4u w = *(const v4u*)(CV + (size_t)row * WC + p8);
      float x[8] = {bflo(w.x), bfhi(w.x), bflo(w.y), bfhi(w.y), bflo(w.z), bfhi(w.z), bflo(w.w), bfhi(w.w)}; float s1 = 0.f;
#pragma unroll
      for (int e = 0; e < 8; ++e) s1 += x[e];
#pragma unroll
      for (int o = 1; o < 32; o <<= 1) s1 += __shfl_xor(s1, o);
      const float mean = s1 * (1.f / 256.f); float s2 = 0.f;
#pragma unroll
      for (int e = 0; e < 8; ++e) { x[e] -= mean; s2 += x[e] * x[e]; }
#pragma unroll
      for (int o = 1; o < 32; o <<= 1) s2 += __shfl_xor(s2, o);
      const float rstd = 1.0f / sqrtf(s2 * (1.f / 256.f) + 1e-5f);
#pragma unroll
      for (int e = 0; e < 8; ++e) { const float y = x[e] * rstd * g_cv[p8 + e] + b_cv[p8 + e]; vn[i * 256 + p8 + e] = y; out_cv[(size_t)(b * DS + i) * WC + p8 + e] = y; } }
    LDS_WAIT(); __syncthreads();
    { const int g = p8 >> 6; float s[8];
#pragma unroll
      for (int e = 0; e < 8; ++e) s[e] = b_s[g * 128 + i];
      for (int j = 0; j < DS; ++j) { const float w = w_s[(size_t)(g * 128 + i) * 128 + j];
#pragma unroll
          for (int e = 0; e < 8; ++e) s[e] += w * vn[j * 256 + p8 + e]; }
      const v4u uw = *(const v4u*)(CU + (size_t)row * WC + p8);
      const float uu[8] = {bflo(uw.x), bfhi(uw.x), bflo(uw.y), bfhi(uw.y), bflo(uw.z), bfhi(uw.z), bflo(uw.w), bfhi(uw.w)}; float ss = 0.f;
#pragma unroll
      for (int e = 0; e < 8; ++e) { s[e] *= uu[e]; ss += s[e] * s[e]; }
#pragma unroll
      for (int o = 1; o < 32; o <<= 1) ss += __shfl_xor(ss, o);
      const float rs = 1.0f / sqrtf(ss * (1.f / 256.f) + 1e-6f);
      v4u o; o.x = pk2(s[0] * rs * g_c_out[p8], s[1] * rs * g_c_out[p8 + 1]); o.y = pk2(s[2] * rs * g_c_out[p8 + 2], s[3] * rs * g_c_out[p8 + 3]);
      o.z = pk2(s[4] * rs * g_c_out[p8 + 4], s[5] * rs * g_c_out[p8 + 5]); o.w = pk2(s[6] * rs * g_c_out[p8 + 6], s[7] * rs * g_c_out[p8 + 7]);
      *(v4u*)(CAT + (size_t)row * D + 768 + p8) = o; }
    LDS_WAIT(); __syncthreads();
}
DI bf16x8 cvt8(const f32x4 a, const f32x4 b) { return pack8(a, b); }
DI void sattn_unit(int b, int h, const bf16* Qb, const bf16* Kb, const bf16* Vb, const float* SM, const float* b_f, float* out_lf, const float* ck, const float* cv, const float* clf, bf16* CAT, float* SSQ, LAS unsigned char* lds, int tid, int lane, int wid) {
    asm volatile("" : "+v"(tid), "+v"(lane));
    LAS float* wtot = (LAS float*)(lds + 4096);
    LAS float* Es = (LAS float*)(lds + 4096 + 64);
    LAS float* alS = (LAS float*)(lds + 8192) + wid * 16;
    LAS float* comb = (LAS float*)(lds + 40960);
    LAS float* DkS = (LAS float*)(lds + 76800) + wid * 512;
    const int rowq0 = MP + b * DS, fr = lane & 15, fq = lane >> 4;
    if (tid < DS) { float e = 0.f; const float bfh = b_f[h]; for (int t = 0; t <= tid; ++t) { const float lf = logsig_f(SM[(size_t)h * M + rowq0 + t] + bfh); e += lf; if (t == tid) out_lf[(size_t)(b * DS + t) * NHA + h] = lf; } Es[tid] = e; }
    { float Dk[8]; float tot = 0.f; const float* clfb = clf + (size_t)b * PAST * NHA + h;
#pragma unroll
      for (int tt = 0; tt < 8; ++tt) { Dk[tt] = clfb[(size_t)(512 * wid + 64 * tt + lane) * NHA]; tot += Dk[tt]; }
      tot = wave_sum(tot);
      if (lane == 0) wtot[wid] = tot;
      LDS_WAIT(); __syncthreads();
      float after = 0.f;
      for (int w = wid + 1; w < 8; ++w) after += wtot[w];
#pragma unroll
      for (int tt = 7; tt >= 0; --tt) { const float inc = wave_incl_scan(Dk[tt], lane); const float ttot = __shfl(inc, 63); DkS[64 * tt + lane] = (after + (ttot - inc)) * LOG2E; after += ttot; } }
    LDS_WAIT(); asm volatile("" ::: "memory");
    const float Eq = Es[fr] * LOG2E;
    bf16x8 Qf[2];
#pragma unroll
    for (int ks = 0; ks < 2; ++ks) Qf[ks] = *(const bf16x8*)(Qb + (size_t)(rowq0 + fr) * WA + h * HD + 32 * ks + 8 * fq);
    float m = -INFINITY, l = 0.f; f32x4 O[4];
#pragma unroll
    for (int T = 0; T < 4; ++T) O[T] = (f32x4){0.f, 0.f, 0.f, 0.f};
    const f32x4 z4 = (f32x4){0.f, 0.f, 0.f, 0.f};
    if (wid == 0) {
        const bf16* kp = Kb + (size_t)(rowq0 + fr) * WA + h * HD + 8 * fq;
        f32x4 S = MFMA16(*(const bf16x8*)kp, Qf[0], z4); S = MFMA16(*(const bf16x8*)(kp + 32), Qf[1], S);
        const f32x4 Ek = *(const LAS f32x4*)(Es + 4 * fq); float p[4]; float mx = -INFINITY;
#pragma unroll
        for (int r = 0; r < 4; ++r) { p[r] = (4 * fq + r <= fr) ? S[r] + Eq - Ek[r] * LOG2E : -INFINITY; mx = fmaxf(mx, p[r]); }
        mx = fmaxf(mx, __shfl_xor(mx, 16)); mx = fmaxf(mx, __shfl_xor(mx, 32));
        m = mx; float ps = 0.f;
#pragma unroll
        for (int r = 0; r < 4; ++r) { p[r] = __builtin_amdgcn_exp2f(p[r] - m); ps += p[r]; }
        l = ps;
        const bf16x8 Pa = pack8((f32x4){p[0], p[1], p[2], p[3]}, z4);
        v2u vw[4];
#pragma unroll
        for (int r = 0; r < 4; ++r) vw[r] = *(const v2u*)(Vb + (size_t)(rowq0 + 4 * fq + r) * WA + h * HD + 4 * fr);
#pragma unroll
        for (int T = 0; T < 4; ++T) { v4u bw;
            const unsigned e0 = (T & 2) ? vw[0].y : vw[0].x, e1 = (T & 2) ? vw[1].y : vw[1].x, e2 = (T & 2) ? vw[2].y : vw[2].x, e3 = (T & 2) ? vw[3].y : vw[3].x;
            const unsigned h0 = (T & 1) ? (e0 >> 16) : (e0 & 0xffffu), h1 = (T & 1) ? (e1 >> 16) : (e1 & 0xffffu), h2 = (T & 1) ? (e2 >> 16) : (e2 & 0xffffu), h3 = (T & 1) ? (e3 >> 16) : (e3 & 0xffffu);
            bw.x = h0 | (h1 << 16); bw.y = h2 | (h3 << 16); bw.z = 0u; bw.w = 0u;
            O[T] = MFMA16(Pa, __builtin_bit_cast(bf16x8, bw), O[T]); }
    }
    const float* kbase = ck + (((size_t)b * PAST + 512 * wid + fr) * NHA + h) * HD + 8 * fq;
    const float* vbase = cv + (((size_t)b * PAST + 512 * wid + 4 * fq) * NHA + h) * HD + 4 * fr;
    f32x4 Kr[4][2][2];
#pragma unroll
    for (int j = 0; j < 4; ++j)
#pragma unroll
        for (int ks = 0; ks < 2; ++ks) { const float* p = kbase + (size_t)(16 * j) * NHA * HD + 32 * ks; Kr[j][ks][0] = *(const f32x4*)p; Kr[j][ks][1] = *(const f32x4*)(p + 4); }
#pragma unroll 1
    for (int tt = 0; tt < 8; ++tt) {
        f32x4 Vr[2][8];
#pragma unroll
        for (int kk = 0; kk < 2; ++kk)
#pragma unroll
            for (int s8 = 0; s8 < 8; ++s8) Vr[kk][s8] = *(const f32x4*)(vbase + (size_t)(64 * tt + 16 * (2 * kk + (s8 >> 2)) + (s8 & 3)) * NHA * HD);
        f32x4 S[4];
#pragma unroll
        for (int j = 0; j < 4; ++j) { S[j] = MFMA16(cvt8(Kr[j][0][0], Kr[j][0][1]), Qf[0], z4); S[j] = MFMA16(cvt8(Kr[j][1][0], Kr[j][1][1]), Qf[1], S[j]); }
        if (tt < 7) {
#pragma unroll
            for (int j = 0; j < 4; ++j)
#pragma unroll
                for (int ks = 0; ks < 2; ++ks) { const float* p = kbase + (size_t)(64 * (tt + 1) + 16 * j) * NHA * HD + 32 * ks; Kr[j][ks][0] = *(const f32x4*)p; Kr[j][ks][1] = *(const f32x4*)(p + 4); }
        }
        float mx = -INFINITY;
#pragma unroll
        for (int j = 0; j < 4; ++j) { const f32x4 Dv = *(const LAS f32x4*)(DkS + 64 * tt + 16 * j + 4 * fq);
#pragma unroll
            for (int r = 0; r < 4; ++r) { S[j][r] += Eq + Dv[r]; mx = fmaxf(mx, S[j][r]); } }
        mx = fmaxf(mx, __shfl_xor(mx, 16)); mx = fmaxf(mx, __shfl_xor(mx, 32));
        const float mn = fmaxf(m, mx), al = __builtin_amdgcn_exp2f(m - mn); m = mn;
        if (fq == 0) alS[fr] = al;
        float ps = 0.f;
#pragma unroll
        for (int j = 0; j < 4; ++j)
#pragma unroll
            for (int r = 0; r < 4; ++r) { S[j][r] = __builtin_amdgcn_exp2f(S[j][r] - mn); ps += S[j][r]; }
        l = l * al + ps;
        const bf16x8 P0 = pack8(S[0], S[1]), P1 = pack8(S[2], S[3]);
        LDS_WAIT(); asm volatile("" ::: "memory");
        const f32x4 alq = *(const LAS f32x4*)(alS + 4 * fq);
#pragma unroll
        for (int T = 0; T < 4; ++T) { O[T] = O[T] * alq;
            const bf16x8 B0 = pack8((f32x4){Vr[0][0][T], Vr[0][1][T], Vr[0][2][T], Vr[0][3][T]}, (f32x4){Vr[0][4][T], Vr[0][5][T], Vr[0][6][T], Vr[0][7][T]});
            const bf16x8 B1 = pack8((f32x4){Vr[1][0][T], Vr[1][1][T], Vr[1][2][T], Vr[1][3][T]}, (f32x4){Vr[1][4][T], Vr[1][5][T], Vr[1][6][T], Vr[1][7][T]});
            O[T] = MFMA16(P0, B0, O[T]); O[T] = MFMA16(P1, B1, O[T]); }
        asm volatile("" ::: "memory");
    }
    l += __shfl_xor(l, 16); l += __shfl_xor(l, 32);
    { LAS float* cw = comb + wid * 1056;
      if (fq == 0) { cw[fr] = m; cw[16 + fr] = l; }
#pragma unroll
      for (int T = 0; T < 4; ++T)
#pragma unroll
          for (int r = 0; r < 4; ++r) cw[32 + (4 * fq + r) * 64 + 4 * fr + T] = O[T][r]; }
    LDS_WAIT(); __syncthreads();
    { const int i = tid >> 5, d2 = (tid & 31) * 2; float mm = -INFINITY;
#pragma unroll
      for (int w = 0; w < 8; ++w) mm = fmaxf(mm, comb[w * 1056 + i]);
      float L = 0.f, o0 = 0.f, o1 = 0.f;
#pragma unroll
      for (int w = 0; w < 8; ++w) { const float f = __builtin_amdgcn_exp2f(comb[w * 1056 + i] - mm); L += comb[w * 1056 + 16 + i] * f; o0 += comb[w * 1056 + 32 + i * 64 + d2] * f; o1 += comb[w * 1056 + 32 + i * 64 + d2 + 1] * f; }
      const float rl = 1.0f / L;
      *(unsigned*)(CAT + (size_t)(rowq0 + i) * D + h * HD + d2) = pk2(o0 * rl, o1 * rl);
      float sq = (o0 * rl) * (o0 * rl) + (o1 * rl) * (o1 * rl);
      sq += __shfl_xor(sq, 1); sq += __shfl_xor(sq, 2); sq += __shfl_xor(sq, 4); sq += __shfl_xor(sq, 8); sq += __shfl_xor(sq, 16);
      if ((tid & 31) == 0) SSQ[(size_t)(rowq0 + i) * 8 + h] = sq; }
    LDS_WAIT(); __syncthreads();
}
DI void sgdn_unit(int b, int h, const bf16* BQKV, const float* SM, float a_log, float dt_bias, const float* convw, const float* st_conv, const float* st_S, const bf16* BZ, const float* g_b_out, bf16* CAT, float* out_conv, float* out_S, LAS unsigned char* L, int lane) {
    asm volatile("" : "+v"(lane));
    LAS float* qs = (LAS float*)L; LAS float* ks = qs + DS * 64; LAS float* vs = ks + DS * 64;
    const int row0 = MP + b * DS;
#pragma unroll
    for (int type = 0; type < 3; ++type) { const int cb = type * WB + h * HD + lane; float x[DS + 3];
#pragma unroll
        for (int j = 0; j < 3; ++j) x[j] = st_conv[(size_t)(b * 3 + j) * 1152 + cb];
#pragma unroll
        for (int t = 0; t < DS; ++t) x[3 + t] = bf2f(BQKV[(size_t)(row0 + t) * 1152 + cb]);
        const float w0 = convw[cb], w1 = convw[1152 + cb], w2 = convw[2 * 1152 + cb], w3 = convw[3 * 1152 + cb];
#pragma unroll
        for (int j = 0; j < 3; ++j) out_conv[(size_t)(b * 3 + j) * 1152 + cb] = x[DS + j];
#pragma unroll
        for (int t = 0; t < DS; ++t) { const float y = pg8::silu_f(w0 * x[t] + w1 * x[t + 1] + w2 * x[t + 2] + w3 * x[t + 3]);
            if (type == 2) vs[t * 64 + lane] = y;
            else { const float rn = 1.0f / sqrtf(wave_sum(y * y) + 1e-6f); if (type == 0) qs[t * 64 + lane] = y * rn * 0.125f; else ks[t * 64 + lane] = y * rn; } }
        asm volatile("" ::: "memory"); }
    LDS_WAIT(); asm volatile("" ::: "memory");
    float S[64];
#pragma unroll
    for (int d = 0; d < 64; ++d) S[d] = st_S[((size_t)(b * NHB + h) * 64 + d) * 64 + lane];
    const float gbo = g_b_out[lane];
    for (int t = 0; t < DS; ++t) {
        const float a = __expf(gdn_decay_f(SM[(size_t)(6 + h) * M + row0 + t], a_log, dt_bias)), beta = sigmoid_f(SM[(size_t)(12 + h) * M + row0 + t]);
        float r = 0.f;
#pragma unroll
        for (int d4 = 0; d4 < 16; ++d4) { const f32x4 kv = *(const LAS f32x4*)(ks + t * 64 + 4 * d4); r += S[4 * d4] * kv.x + S[4 * d4 + 1] * kv.y + S[4 * d4 + 2] * kv.z + S[4 * d4 + 3] * kv.w; }
        const float vt = vs[t * 64 + lane];
        const float uu = beta * (vt - a * r); float o = 0.f;
#pragma unroll
        for (int d4 = 0; d4 < 16; ++d4) { const f32x4 kv = *(const LAS f32x4*)(ks + t * 64 + 4 * d4); const f32x4 qv = *(const LAS f32x4*)(qs + t * 64 + 4 * d4);
            S[4 * d4] = a * S[4 * d4] + kv.x * uu; S[4 * d4 + 1] = a * S[4 * d4 + 1] + kv.y * uu; S[4 * d4 + 2] = a * S[4 * d4 + 2] + kv.z * uu; S[4 * d4 + 3] = a * S[4 * d4 + 3] + kv.w * uu;
            o += S[4 * d4] * qv.x + S[4 * d4 + 1] * qv.y + S[4 * d4 + 2] * qv.z + S[4 * d4 + 3] * qv.w; }
        const float rs = 1.0f / sqrtf(wave_sum(o * o) * (1.f / 64.f) + 1e-6f);
        const float z = bf2f(BZ[(size_t)(row0 + t) * WB + h * HD + lane]);
        CAT[(size_t)(row0 + t) * D + WA + h * HD + lane] = f2bf(o * rs * gbo * z);
    }
#pragma unroll
    for (int d = 0; d < 64; ++d) out_S[((size_t)(b * NHB + h) * 64 + d) * 64 + lane] = S[d];
    LDS_WAIT(); asm volatile("" ::: "memory");
}
#define CONV_LOAD(xw, type, c16) do { const int cb_ = (type) * WB + h * HD; _Pragma("unroll") for (int q_ = 0; q_ < 2; ++q_) _Pragma("unroll") for (int tap_ = 0; tap_ < 4; ++tap_) { \
        const int tr_ = 64 * n + lane - 3 + tap_; xw[q_][tap_] = (v4u){0u, 0u, 0u, 0u}; if (tr_ >= 0) xw[q_][tap_] = *(const v4u*)(BQKV + (size_t)(row - 3 + tap_) * 1152 + cb_ + (2 * (c16) + q_) * 8); } } while (0)
DI float conv_slab(const v4u (&xw)[2][4], LAS bf16* buf, LAS bf16* bufT, int mode  , int type, int h, int c16, int lane, const float* convw, float* out_conv_b) {
    const int cb = type * WB + h * HD; float ss = 0.f;
#pragma unroll
    for (int q = 0; q < 2; ++q) { const int c8 = 2 * c16 + q; float a[8];
#pragma unroll
        for (int e = 0; e < 8; ++e) a[e] = 0.f;
#pragma unroll
        for (int tap = 0; tap < 4; ++tap) { const v4u w4 = xw[q][tap];
            const float xs[8] = {bflo(w4.x), bfhi(w4.x), bflo(w4.y), bfhi(w4.y), bflo(w4.z), bfhi(w4.z), bflo(w4.w), bfhi(w4.w)};
            typedef const __attribute__((address_space(4))) f32x4* cw4_t;
            const f32x4 w0 = *(cw4_t)(convw + tap * 1152 + cb + c8 * 8), w1 = *(cw4_t)(convw + tap * 1152 + cb + c8 * 8 + 4);
            a[0] += w0.x * xs[0]; a[1] += w0.y * xs[1]; a[2] += w0.z * xs[2]; a[3] += w0.w * xs[3]; a[4] += w1.x * xs[4]; a[5] += w1.y * xs[5]; a[6] += w1.z * xs[6]; a[7] += w1.w * xs[7];
            if (tap == 3 && out_conv_b && lane >= 61) { float* op = out_conv_b + (size_t)(lane - 61) * 1152 + cb + c8 * 8; *(f32x4*)op = (f32x4){xs[0], xs[1], xs[2], xs[3]}; *(f32x4*)(op + 4) = (f32x4){xs[4], xs[5], xs[6], xs[7]}; } }
#pragma unroll
        for (int e = 0; e < 8; ++e) { a[e] = pg8::silu_f(a[e]); ss += a[e] * a[e]; }
        v4u w; w.x = pk2(a[0], a[1]); w.y = pk2(a[2], a[3]); w.z = pk2(a[4], a[5]); w.w = pk2(a[6], a[7]);
        if (mode & 1) *(LAS v4u*)(buf + lane * 64 + 8 * c8) = w;
        if (mode & 2) {
            bufT[(8 * c8 + 0) * 64 + lane] = (bf16)(w.x & 0xffffu); bufT[(8 * c8 + 1) * 64 + lane] = (bf16)(w.x >> 16); bufT[(8 * c8 + 2) * 64 + lane] = (bf16)(w.y & 0xffffu); bufT[(8 * c8 + 3) * 64 + lane] = (bf16)(w.y >> 16);
            bufT[(8 * c8 + 4) * 64 + lane] = (bf16)(w.z & 0xffffu); bufT[(8 * c8 + 5) * 64 + lane] = (bf16)(w.z >> 16); bufT[(8 * c8 + 6) * 64 + lane] = (bf16)(w.w & 0xffffu); bufT[(8 * c8 + 7) * 64 + lane] = (bf16)(w.w >> 16); } }
    return ss;
}
DI float conv_rows(v4u (&xa)[2][4], LAS bf16* buf, LAS bf16* bufT, int mode, int type, int ntype, int h, int n, int row, int lane, const bf16* BQKV, const float* convw, float* out_conv_b  ) {
    v4u xb[2][4]; float ss = 0.f;
    CONV_LOAD(xb, type, 1); ss += conv_slab(xa, buf, bufT, mode, type, h, 0, lane, convw, out_conv_b);
    CONV_LOAD(xa, type, 2); ss += conv_slab(xb, buf, bufT, mode, type, h, 1, lane, convw, out_conv_b);
    CONV_LOAD(xb, type, 3); ss += conv_slab(xa, buf, bufT, mode, type, h, 2, lane, convw, out_conv_b);
    if (ntype >= 0) CONV_LOAD(xa, ntype, 0);
    ss += conv_slab(xb, buf, bufT, mode, type, h, 3, lane, convw, out_conv_b);
    return ss;
}
#define CONV_LOAD2(x, type) do { const int cb_ = (type) * WB + h * HD + 8 * (lane & 7); const int tb_ = 8 * (lane >> 3) - 3; _Pragma("unroll") for (int i_ = 0; i_ < 11; ++i_) { \
        const int tr_ = 64 * n + tb_ + i_; x[i_] = *(const v4u*)(BQKV + (size_t)(row0 + (tr_ < 0 ? 0 : tb_ + i_)) * 1152 + cb_); if (tr_ < 0) x[i_] = (v4u){0u, 0u, 0u, 0u}; } } while (0)
DI float conv_rows2(const v4u (&x)[11], LAS bf16* buf, LAS bf16* bufT, int mode, int type, int h, int lane, const float* convw, float* out_conv_b) {
    const int g = lane >> 3, c = lane & 7; const int cb = type * WB + h * HD + 8 * c;
    f32x4 wl[4], wh[4];
#pragma unroll
    for (int tap = 0; tap < 4; ++tap) { wl[tap] = *(const f32x4*)(convw + tap * 1152 + cb); wh[tap] = *(const f32x4*)(convw + tap * 1152 + cb + 4); }
    unsigned ow[8][4]; float ss[8];
#pragma unroll
    for (int j = 0; j < 8; ++j) ss[j] = 0.f;
#pragma unroll
    for (int wi = 0; wi < 4; ++wi) { float xl[11], xh[11];
#pragma unroll
        for (int i = 0; i < 11; ++i) { const unsigned w = x[i][wi]; xl[i] = bflo(w); xh[i] = bfhi(w); }
        float w0[4], w1[4];
#pragma unroll
        for (int tap = 0; tap < 4; ++tap) { w0[tap] = wi < 2 ? wl[tap][2 * (wi & 1)] : wh[tap][2 * (wi & 1)]; w1[tap] = wi < 2 ? wl[tap][2 * (wi & 1) + 1] : wh[tap][2 * (wi & 1) + 1]; }
#pragma unroll
        for (int j = 0; j < 8; ++j) { float a0 = 0.f, a1 = 0.f;
#pragma unroll
            for (int tap = 0; tap < 4; ++tap) { a0 += w0[tap] * xl[j + tap]; a1 += w1[tap] * xh[j + tap]; }
            a0 = pg8::silu_f(a0); a1 = pg8::silu_f(a1); ss[j] += a0 * a0 + a1 * a1; ow[j][wi] = pk2(a0, a1); } }
    if (out_conv_b && g == 7) {
#pragma unroll
        for (int j3 = 0; j3 < 3; ++j3) { const v4u w4 = x[8 + j3]; float* op = out_conv_b + (size_t)j3 * 1152 + cb;
            *(f32x4*)op = (f32x4){bflo(w4.x), bfhi(w4.x), bflo(w4.y), bfhi(w4.y)}; *(f32x4*)(op + 4) = (f32x4){bflo(w4.z), bfhi(w4.z), bflo(w4.w), bfhi(w4.w)}; } }
    if (mode & 1) {
#pragma unroll
        for (int j = 0; j < 8; ++j) { v4u w; w.x = ow[j][0]; w.y = ow[j][1]; w.z = ow[j][2]; w.w = ow[j][3]; *(LAS v4u*)(buf + (8 * g + j) * 64 + 8 * c) = w; } }
    if (mode & 2) {
#pragma unroll
        for (int e = 0; e < 8; ++e) { const int wi = e >> 1; v4u w;
            if (e & 1) { w.x = (ow[0][wi] >> 16) | (ow[1][wi] & 0xffff0000u); w.y = (ow[2][wi] >> 16) | (ow[3][wi] & 0xffff0000u); w.z = (ow[4][wi] >> 16) | (ow[5][wi] & 0xffff0000u); w.w = (ow[6][wi] >> 16) | (ow[7][wi] & 0xffff0000u); }
            else { w.x = (ow[0][wi] & 0xffffu) | (ow[1][wi] << 16); w.y = (ow[2][wi] & 0xffffu) | (ow[3][wi] << 16); w.z = (ow[4][wi] & 0xffffu) | (ow[5][wi] << 16); w.w = (ow[6][wi] & 0xffffu) | (ow[7][wi] << 16); }
            *(LAS v4u*)(bufT + (8 * c + e) * 64 + 8 * g) = w; } }
    float my = 0.f;
#pragma unroll
    for (int j = 0; j < 8; ++j) { float t = ss[j]; t += __shfl_xor(t, 1); t += __shfl_xor(t, 2); t += __shfl_xor(t, 4); my = (c == j) ? t : my; }
    return my;
}
__host__ __device__ constexpr int TRIG(int i) { return i <= 0 ? 0 : (((i - 1) >> 2) + 1) * ((i - 1) - 2 * ((i - 1) >> 2)); }
static_assert(TRIG(1) == 0 && TRIG(2) == 1 && TRIG(5) == 4 && TRIG(6) == 6 && TRIG(64) == 528, "triangular packing");
DI void prep_unit(int u, const bf16* BQKV, const float* SM, const float* a_log, const float* dt_bias, const float* convw, unsigned char* prep, float* GLarr, float* out_conv, LAS unsigned char* L, int lane) {
    asm volatile("" : "+v"(lane));
    const int h = u % NHB, bn = u / NHB, n = bn % NCH, b = bn / NCH; const int row0 = b * SEQ + 64 * n, row = row0 + lane; const int fr = lane & 15, fq = lane >> 4;
    LAS bf16* B1 = (LAS bf16*)L; LAS bf16* B2 = (LAS bf16*)(L + 8192); LAS float* Abuf = (LAS float*)(L + 8192);
    LAS float* Gs = (LAS float*)(L + 16640); LAS float* Bs = Gs + 64; LAS float* Ks = Gs + 128; LAS float* RKs = Gs + 192; LAS float* RQs = Gs + 256;
    unsigned char* slot = prep + ((size_t)(b * NHB + h) * NCH + n) * 40960;
    unsigned char* dummy = (unsigned char*)GLarr + 524288;
    float* ocb = (n == NCH - 1) ? out_conv + (size_t)b * 3 * 1152 : nullptr;
    const float gl = gdn_decay_f(SM[(size_t)(6 + h) * M + row], a_log[h], dt_bias[h]), beta = sigmoid_f(SM[(size_t)(12 + h) * M + row]);
    const float G = wave_incl_scan(gl, lane), eG = __expf(G), Gtot = __shfl(G, 63);
    if (lane == 0) GLarr[(b * NHB + h) * NCH + n] = __expf(Gtot);
    const int pl = pinv(lane);
    v4u xa[2][4]; CONV_LOAD(xa, 1, 0);
    const float rnk = 1.0f / sqrtf(conv_rows(xa, B1, B1, 1, 1, 0, h, n, row, lane, BQKV, convw, ocb) + 1e-6f);
    const float rnq = 0.125f / sqrtf(conv_rows(xa, B2, B2, 1, 0, -1, h, n, row, lane, BQKV, convw, ocb) + 1e-6f);
    Gs[lane] = G; Bs[lane] = beta; Ks[lane] = beta * eG * rnk; RKs[lane] = rnk; RQs[lane] = rnq;
    LDS_WAIT(); asm volatile("" ::: "memory");
    {
      const float ksc = rnk * __expf(Gtot - G), qsc = rnq * eG;
      unsigned char* kd = slot + 32768 + (pl & 7) * 2; const int pc = pl >> 3;
#pragma unroll 1
      for (int c8 = 0; c8 < 8; ++c8) { const v4u w = *(const LAS v4u*)(B1 + lane * 64 + 8 * c8); unsigned char* p = kd + c8 * 8 * 128; const int sw = (4 * c8) & 7;
          *(bf16*)(p + 0 * 128 + ((pc ^ (sw + 0)) << 4)) = f2bf(bflo(w.x) * ksc); *(bf16*)(p + 1 * 128 + ((pc ^ (sw + 0)) << 4)) = f2bf(bfhi(w.x) * ksc);
          *(bf16*)(p + 2 * 128 + ((pc ^ (sw + 1)) << 4)) = f2bf(bflo(w.y) * ksc); *(bf16*)(p + 3 * 128 + ((pc ^ (sw + 1)) << 4)) = f2bf(bfhi(w.y) * ksc);
          *(bf16*)(p + 4 * 128 + ((pc ^ (sw + 2)) << 4)) = f2bf(bflo(w.z) * ksc); *(bf16*)(p + 5 * 128 + ((pc ^ (sw + 2)) << 4)) = f2bf(bfhi(w.z) * ksc);
          *(bf16*)(p + 6 * 128 + ((pc ^ (sw + 3)) << 4)) = f2bf(bflo(w.w) * ksc); *(bf16*)(p + 7 * 128 + ((pc ^ (sw + 3)) << 4)) = f2bf(bfhi(w.w) * ksc); }
#pragma unroll 1
      for (int g = 0; g < 8; ++g) { const int d0 = 32 * (g >> 2) + 4 * (g & 3); const v2u a = *(const LAS v2u*)(B2 + lane * 64 + d0), c = *(const LAS v2u*)(B2 + lane * 64 + d0 + 16);
          v4u w; w.x = pk2(bflo(a.x) * qsc, bfhi(a.x) * qsc); w.y = pk2(bflo(a.y) * qsc, bfhi(a.y) * qsc); w.z = pk2(bflo(c.x) * qsc, bfhi(c.x) * qsc); w.w = pk2(bflo(c.y) * qsc, bfhi(c.y) * qsc);
          *(v4u*)(slot + 16384 + lane * 128 + ((g ^ ((lane >> 1) & 7)) << 4)) = w; } }
    { bf16x8 kf[4][2], qf[4][2];
#pragma unroll
      for (int mt = 0; mt < 4; ++mt)
#pragma unroll
          for (int ks = 0; ks < 2; ++ks) { kf[mt][ks] = *(const LAS bf16x8*)(B1 + (16 * mt + fr) * 64 + 32 * ks + 8 * fq); qf[mt][ks] = *(const LAS bf16x8*)(B2 + (16 * mt + fr) * 64 + 32 * ks + 8 * fq); }
      LDS_WAIT(); asm volatile("" : "+v"(qf[0][0]), "+v"(qf[1][0]), "+v"(qf[2][0]), "+v"(qf[3][0]), "+v"(qf[0][1]), "+v"(qf[1][1]), "+v"(qf[2][1]), "+v"(qf[3][1]) :: "memory");
#pragma unroll
      for (int mi = 0; mi < 4; ++mi) { const f32x4 Gi = *(const LAS f32x4*)(Gs + 16 * mi + 4 * fq), Bi = *(const LAS f32x4*)(Bs + 16 * mi + 4 * fq), RKi = *(const LAS f32x4*)(RKs + 16 * mi + 4 * fq), RQi = *(const LAS f32x4*)(RQs + 16 * mi + 4 * fq);
#pragma unroll
          for (int nj = 0; nj < 4; ++nj) { const int j = 16 * nj + fr; const int pj = pinv(j); unsigned char* qkp = slot + 24576 + (16 * mi + 4 * fq) * 128 + (pj & 7) * 2; const int pjc = pj >> 3, swq = (8 * mi + 2 * fq) & 7;
              if (nj <= mi) { const float Gj = Gs[j], RKj = RKs[j];
                  f32x4 a = MFMA16(kf[mi][0], kf[nj][0], ((f32x4){0.f, 0.f, 0.f, 0.f})); a = MFMA16(kf[mi][1], kf[nj][1], a);
                  f32x4 c = MFMA16(qf[mi][0], kf[nj][0], ((f32x4){0.f, 0.f, 0.f, 0.f})); c = MFMA16(qf[mi][1], kf[nj][1], c);
#pragma unroll
                  for (int r = 0; r < 4; ++r) { const int i = 16 * mi + 4 * fq + r; const float dec = __expf(fminf(Gi[r] - Gj, 0.f)) * RKj;
                      const int nn = i - 1, qq = nn >> 2, tg = (qq + 1) * (nn - 2 * qq);
                      if (nj < mi || j < ((i + 3) & ~3)) Abuf[4 * tg + j] = (j < i) ? Bi[r] * RKi[r] * a[r] * dec : 0.f;
                      *(bf16*)(qkp + r * 128 + ((pjc ^ (swq + (r >> 1))) << 4)) = f2bf((j <= i) ? RQi[r] * c[r] * dec : 0.f); }
              } else {
#pragma unroll
                  for (int r = 0; r < 4; ++r) *(bf16*)(qkp + r * 128 + ((pjc ^ (swq + (r >> 1))) << 4)) = (bf16)0; } } } }
    LDS_WAIT(); asm volatile("" ::: "memory");
    for (int pp = 0; pp < 2; ++pp) {
        const bool isk = (pp == 0);
        if (!isk) { CONV_LOAD(xa, 2, 0); (void)conv_rows(xa, B1, B1, 1, 2, -1, h, n, row, lane, BQKV, convw, ocb); LDS_WAIT(); asm volatile("" ::: "memory"); }
        const LAS float* scs = isk ? Ks : Bs;
        unsigned char* ob = isk ? slot + (pl & 7) * 2 : dummy + (lane & 7) * 2; const int pc = pl >> 3; const int rstep = isk ? 128 : 0;
        float x[64];
#pragma unroll
        for (int i = 0; i < 64; ++i) {
            float acc = scs[i] * bf2f(B1[i * 64 + lane]); float s0 = 0.f, s1 = 0.f, s2 = 0.f, s3 = 0.f;
#pragma unroll
            for (int j4 = 0; j4 < (i + 3) / 4; ++j4) { const f32x4 a = *(const LAS f32x4*)(Abuf + 4 * (TRIG(i) + j4));
                if (4 * j4 < i) s0 += a.x * x[4 * j4]; if (4 * j4 + 1 < i) s1 += a.y * x[4 * j4 + 1]; if (4 * j4 + 2 < i) s2 += a.z * x[4 * j4 + 2]; if (4 * j4 + 3 < i) s3 += a.w * x[4 * j4 + 3]; }
            acc -= (s0 + s1) + (s2 + s3);
            x[i] = acc; *(bf16*)(ob + i * rstep + ((pc ^ ((i >> 1) & 7)) << 4)) = f2bf(acc);
            if ((i & 7) == 7) asm volatile("" ::: "memory");
        }
        if (!isk) {
#pragma unroll
            for (int g = 0; g < 8; ++g) { const int t0 = 32 * (g >> 2) + 4 * (g & 3); v4u w; w.x = pk2(x[t0], x[t0 + 1]); w.y = pk2(x[t0 + 2], x[t0 + 3]); w.z = pk2(x[t0 + 16], x[t0 + 17]); w.w = pk2(x[t0 + 18], x[t0 + 19]);
                *(v4u*)(slot + 8192 + lane * 128 + ((g ^ ((lane >> 1) & 7)) << 4)) = w; } }
    }
    LDS_WAIT(); asm volatile("" ::: "memory");
}

typedef float f32x2s __attribute__((ext_vector_type(2))); typedef __bf16 bf16x2s __attribute__((ext_vector_type(2)));
DI unsigned pk2s(float lo, float hi) { const f32x2s v = {lo, hi}; const bf16x2s b = __builtin_convertvector(v, bf16x2s); return __builtin_bit_cast(unsigned, b); }
DI bf16x8 pack8s(const f32x4 a, const f32x4 b) { v4u p; p.x = pk2s(a[0], a[1]); p.y = pk2s(a[2], a[3]); p.z = pk2s(b[0], b[1]); p.w = pk2s(b[2], b[3]); return __builtin_bit_cast(bf16x8, p); }
DI void prep_unit2(int u, const bf16* BQKV, const float* SM, const float* a_log, const float* dt_bias, const float* convw, unsigned char* prep, float* GLarr, float* out_conv, LAS unsigned char* L, int lane) {
    asm volatile("" : "+v"(lane));
    const int h = u % NHB, bn = u / NHB, n = bn % NCH, b = bn / NCH; const int row0 = b * SEQ + 64 * n, row = row0 + lane; const int fr = lane & 15, fq = lane >> 4;
    LAS bf16* B1 = (LAS bf16*)L; LAS bf16* B2 = (LAS bf16*)(L + 8192);
    LAS float* Gs = (LAS float*)(L + 16384); LAS float* Bs = Gs + 64; LAS float* Ks = Gs + 128; LAS float* RKs = Gs + 192; LAS float* RQs = Gs + 256; LAS float* BRs = Gs + 320; LAS float* KDs = Gs + 384;
    unsigned char* slot = prep + ((size_t)(b * NHB + h) * NCH + n) * 40960;
    float* ocb = (n == NCH - 1) ? out_conv + (size_t)b * 3 * 1152 : nullptr;
    const float gl = gdn_decay_f(SM[(size_t)(6 + h) * M + row], a_log[h], dt_bias[h]), beta = sigmoid_f(SM[(size_t)(12 + h) * M + row]);
    const float G = wave_incl_scan(gl, lane), eG = __expf(G), Gtot = __shfl(G, 63);
    if (lane == 0) GLarr[(b * NHB + h) * NCH + n] = __expf(Gtot);
    v4u xq[11], xk[11]; CONV_LOAD2(xq, 0); CONV_LOAD2(xk, 1);
    const float rnq = 0.125f / sqrtf(conv_rows2(xq, B2, B2, 1, 0, h, lane, convw, ocb) + 1e-6f);
    LDS_WAIT(); asm volatile("" ::: "memory");
    bf16x8 kf[4][2], qf[4][2];
#pragma unroll
    for (int mt = 0; mt < 4; ++mt)
#pragma unroll
        for (int ks = 0; ks < 2; ++ks) qf[mt][ks] = *(const LAS bf16x8*)(B2 + (16 * mt + fr) * 64 + 32 * ks + 8 * fq);
    { Gs[lane] = rnq * eG; LDS_WAIT(); asm volatile("" ::: "memory");
      const int r8 = lane >> 3, cd = lane & 7, d0 = 32 * (cd >> 2) + 4 * (cd & 3);
#pragma unroll 2
      for (int i = 0; i < 8; ++i) { const int t = 8 * i + r8; const float qsc = Gs[t]; const v2u a = *(const LAS v2u*)(B2 + t * 64 + d0), c = *(const LAS v2u*)(B2 + t * 64 + d0 + 16);
          v4u w; w.x = pk2(bflo(a.x) * qsc, bfhi(a.x) * qsc); w.y = pk2(bflo(a.y) * qsc, bfhi(a.y) * qsc); w.z = pk2(bflo(c.x) * qsc, bfhi(c.x) * qsc); w.w = pk2(bflo(c.y) * qsc, bfhi(c.y) * qsc);
          *(v4u*)(slot + 16384 + t * 128 + ((cd ^ ((t >> 1) & 7)) << 4)) = w; } }
    LDS_WAIT(); asm volatile("" : "+v"(qf[0][0]), "+v"(qf[1][0]), "+v"(qf[2][0]), "+v"(qf[3][0]), "+v"(qf[0][1]), "+v"(qf[1][1]), "+v"(qf[2][1]), "+v"(qf[3][1]) :: "memory");
    const float rnk = 1.0f / sqrtf(conv_rows2(xk, B1, B2, 3, 1, h, lane, convw, ocb) + 1e-6f);
    Gs[lane] = G; Bs[lane] = beta; Ks[lane] = beta * eG * rnk; RKs[lane] = rnk; RQs[lane] = rnq; BRs[lane] = beta * rnk; KDs[lane] = rnk * __expf(Gtot - G);
    LDS_WAIT(); asm volatile("" ::: "memory");
#pragma unroll
    for (int mt = 0; mt < 4; ++mt)
#pragma unroll
        for (int ks = 0; ks < 2; ++ks) kf[mt][ks] = *(const LAS bf16x8*)(B1 + (16 * mt + fr) * 64 + 32 * ks + 8 * fq);
    LDS_WAIT(); asm volatile("" : "+v"(kf[0][0]), "+v"(kf[1][0]), "+v"(kf[2][0]), "+v"(kf[3][0]), "+v"(kf[0][1]), "+v"(kf[1][1]), "+v"(kf[2][1]), "+v"(kf[3][1]) :: "memory");
    {
      const int r8 = lane >> 3, cd = lane & 7, t0 = 32 * (cd >> 2) + 4 * (cd & 3);
      const f32x4 sa = *(const LAS f32x4*)(KDs + t0), sb = *(const LAS f32x4*)(KDs + t0 + 16);
#pragma unroll 2
      for (int i = 0; i < 8; ++i) { const int d = 8 * i + r8; const v2u a = *(const LAS v2u*)(B2 + d * 64 + t0), c = *(const LAS v2u*)(B2 + d * 64 + t0 + 16);
          v4u w; w.x = pk2(bflo(a.x) * sa.x, bfhi(a.x) * sa.y); w.y = pk2(bflo(a.y) * sa.z, bfhi(a.y) * sa.w); w.z = pk2(bflo(c.x) * sb.x, bfhi(c.x) * sb.y); w.w = pk2(bflo(c.y) * sb.z, bfhi(c.y) * sb.w);
          *(v4u*)(slot + 32768 + d * 128 + ((cd ^ ((d >> 1) & 7)) << 4)) = w; } }
    const f32x4 z4 = (f32x4){0.f, 0.f, 0.f, 0.f};
#pragma unroll
    for (int mi = 0; mi < 4; ++mi) { const f32x4 Gi = *(const LAS f32x4*)(Gs + 16 * mi + 4 * fq), RQi = *(const LAS f32x4*)(RQs + 16 * mi + 4 * fq);
#pragma unroll
        for (int nj = 0; nj < 4; ++nj) { const int j = 16 * nj + fr; const int pj = pinv(j); unsigned char* qkp = slot + 24576 + (16 * mi + 4 * fq) * 128 + (pj & 7) * 2; const int pjc = pj >> 3, swq = (8 * mi + 2 * fq) & 7;
            if (nj <= mi) { const float Gj = Gs[j], RKj = RKs[j];
                f32x4 c = MFMA16(qf[mi][0], kf[nj][0], z4); c = MFMA16(qf[mi][1], kf[nj][1], c);
#pragma unroll
                for (int r = 0; r < 4; ++r) { const int i = 16 * mi + 4 * fq + r; const float dec = __expf(fminf(Gi[r] - Gj, 0.f)) * RKj;
                    *(bf16*)(qkp + r * 128 + ((pjc ^ (swq + (r >> 1))) << 4)) = f2bf((j <= i) ? RQi[r] * c[r] * dec : 0.f); }
            } else {
#pragma unroll
                for (int r = 0; r < 4; ++r) *(bf16*)(qkp + r * 128 + ((pjc ^ (swq + (r >> 1))) << 4)) = (bf16)0; } } }
    bf16x8 Aop1, Aop2, Aop3a, Aop3b;
    { LAS float* DG = (LAS float*)B1;
      f32x4 Nt[4][4];
#pragma unroll
      for (int mi = 0; mi < 4; ++mi) { const int i = 16 * mi + fr; const float bri = BRs[i], Gi = Gs[i];
#pragma unroll
          for (int nj = 0; nj <= mi; ++nj) { const f32x4 Gj = *(const LAS f32x4*)(Gs + 16 * nj + 4 * fq), RKj = *(const LAS f32x4*)(RKs + 16 * nj + 4 * fq);
              f32x4 t = MFMA16(kf[nj][0], kf[mi][0], z4); t = MFMA16(kf[nj][1], kf[mi][1], t);
              f32x4 v;
#pragma unroll
              for (int r = 0; r < 4; ++r) { const int j = 16 * nj + 4 * fq + r; v[r] = (j < i) ? bri * RKj[r] * __expf(fminf(Gi - Gj[r], 0.f)) * t[r] : 0.f; }
              if (nj == mi) *(LAS f32x4*)(DG + mi * 256 + fr * 16 + 4 * fq) = v; else Nt[mi][nj] = -v; } }
      Aop1 = pack8(Nt[1][0], z4); Aop2 = pack8(Nt[2][0], Nt[2][1]); Aop3a = pack8(Nt[3][0], Nt[3][1]); Aop3b = pack8(Nt[3][2], z4); }
    LDS_WAIT(); asm volatile("" ::: "memory");
    bf16x8 Dop[4];
    { const LAS float* DG = (const LAS float*)B1 + fq * 256; LAS bf16* DIb = (LAS bf16*)(L + 4096);
      float x[16];
#pragma unroll
      for (int r = 0; r < 16; ++r) { float acc = (r == fr) ? 1.f : 0.f;
#pragma unroll
          for (int j4 = 0; j4 < (r + 3) / 4; ++j4) { const f32x4 a = *(const LAS f32x4*)(DG + r * 16 + 4 * j4);
              if (4 * j4 < r) acc -= a.x * x[4 * j4]; if (4 * j4 + 1 < r) acc -= a.y * x[4 * j4 + 1]; if (4 * j4 + 2 < r) acc -= a.z * x[4 * j4 + 2]; if (4 * j4 + 3 < r) acc -= a.w * x[4 * j4 + 3]; }
          x[r] = acc; DIb[fq * 256 + r * 16 + fr] = f2bf(acc); }
      LDS_WAIT(); asm volatile("" ::: "memory");
#pragma unroll
      for (int m = 0; m < 4; ++m) { const v2u d = *(const LAS v2u*)(DIb + m * 256 + fr * 16 + 4 * fq); v4u w; w.x = d.x; w.y = d.y; w.z = 0u; w.w = 0u; Dop[m] = __builtin_bit_cast(bf16x8, w); }
      LDS_WAIT(); asm volatile("" : "+v"(Dop[0]), "+v"(Dop[1]), "+v"(Dop[2]), "+v"(Dop[3]) :: "memory"); }
#define PREP_SOLVE(srcT, SC, STORE) do { _Pragma("unroll") for (int ct = 0; ct < 4; ++ct) { const int col = 16 * ct + fr; f32x4 X[4]; \
        _Pragma("unroll") for (int m = 0; m < 4; ++m) { const v2u rw = *(const LAS v2u*)((srcT) + col * 64 + 16 * m + 4 * fq); const f32x4 sc = *(const LAS f32x4*)((SC) + 16 * m + 4 * fq); \
            X[m] = (f32x4){bflo(rw.x) * sc.x, bfhi(rw.x) * sc.y, bflo(rw.y) * sc.z, bfhi(rw.y) * sc.w}; } \
        X[0] = MFMA16(Dop[0], pack8s(X[0], z4), z4); \
        const bf16x8 b0 = pack8s(X[0], z4); \
        X[1] = MFMA16(Aop1, b0, X[1]); X[1] = MFMA16(Dop[1], pack8s(X[1], z4), z4); \
        const bf16x8 b01 = pack8s(X[0], X[1]); \
        X[2] = MFMA16(Aop2, b01, X[2]); X[2] = MFMA16(Dop[2], pack8s(X[2], z4), z4); \
        X[3] = MFMA16(Aop3a, b01, X[3]); X[3] = MFMA16(Aop3b, pack8s(X[2], z4), X[3]); X[3] = MFMA16(Dop[3], pack8s(X[3], z4), z4); \
        _Pragma("unroll") for (int m = 0; m < 4; ++m) { STORE; } } } while (0)
#define PREP_STORE_W do { const int pd_ = pinv(col); _Pragma("unroll") for (int r = 0; r < 4; ++r) { const int t_ = 16 * m + 4 * fq + r; \
        *(bf16*)(slot + t_ * 128 + (((pd_ >> 3) ^ ((t_ >> 1) & 7)) << 4) + (pd_ & 7) * 2) = (bf16)(pk2s(X[m][r], 0.f) & 0xffffu); } } while (0)
#define PREP_STORE_UV do { v2u w_; w_.x = pk2s(X[m][0], X[m][1]); w_.y = pk2s(X[m][2], X[m][3]); \
        *(v2u*)(slot + 8192 + col * 128 + (((4 * (m >> 1) + fq) ^ ((col >> 1) & 7)) << 4) + (m & 1) * 8) = w_; } while (0)
    v4u xv[11]; CONV_LOAD2(xv, 2);
    PREP_SOLVE(B2, Ks, PREP_STORE_W);
    (void)conv_rows2(xv, B1, B1, 2, 2, h, lane, convw, ocb);
    LDS_WAIT(); asm volatile("" ::: "memory");
    PREP_SOLVE(B1, Bs, PREP_STORE_UV);
#undef PREP_SOLVE
#undef PREP_STORE_W
#undef PREP_STORE_UV
    LDS_WAIT(); asm volatile("" ::: "memory");
}
DI void scan_unit(int bh, const unsigned char* prep, const float* GLarr, const bf16* BZ, const float* g_b_out, bf16* CAT, float* out_S, LAS unsigned char* lds, int tid, int lane, int wid) {
    asm volatile("" : "+v"(tid), "+v"(lane));
    const int b = bh / NHB, h = bh % NHB, rowbase = b * SEQ, fr = lane & 15, fq = lane >> 4, e0 = wid * 16;
    const unsigned char* src = prep + (size_t)bh * NCH * 40960;
    LAS bf16* obuf = (LAS bf16*)(lds + 122880);
    LAS unsigned char* bzs = lds + 139264;
#define SCAN_DMA(n, s) do { _Pragma("unroll") for (int i_ = 0; i_ < 5; ++i_) { const int p_ = wid + 8 * i_; \
        __builtin_amdgcn_global_load_lds((const unsigned*)(src + (size_t)(n) * 40960 + p_ * 1024 + lane * 16), (LAS unsigned*)(lds + (s) * 40960 + p_ * 1024), 16, 0, 0); } } while (0)
#define SCAN_SYNC() do { asm volatile("s_waitcnt vmcnt(0) lgkmcnt(0)" ::: "memory"); __builtin_amdgcn_s_barrier(); asm volatile("" ::: "memory"); } while (0)
#define SCAN_SYNC5() do { asm volatile("s_waitcnt vmcnt(5) lgkmcnt(0)" ::: "memory"); __builtin_amdgcn_s_barrier(); asm volatile("" ::: "memory"); } while (0)
#define SCAN_BZDMA(nc) do { _Pragma("unroll") for (int i_ = 0; i_ < 2; ++i_) { const int t_ = 16 * (wid - 4) + 8 * i_ + (lane >> 3);        \
            __builtin_amdgcn_global_load_lds((const unsigned*)(BZ + ((size_t)rowbase + 64 * (nc) + t_) * WB + h * HD + 8 * (lane & 7)), (LAS unsigned*)(bzs + ((nc) & 1) * 8192 + (16 * (wid - 4) + 8 * i_) * 128), 16, 0, 0); } } while (0)
#define SCAN_POST(nc) do { const LAS bf16* ob_ = obuf + ((nc) & 1) * 4096; const LAS unsigned char* bz_ = bzs + ((nc) & 1) * 8192; const int c4_ = 4 * (lane & 15); \
        _Pragma("unroll") for (int i_ = 0; i_ < 4; ++i_) { const int t_ = 16 * (wid - 4) + 4 * i_ + (lane >> 4); const v2u ow_ = *(const LAS v2u*)(ob_ + t_ * 64 + c4_); \
            const float ox_ = bflo(ow_.x), oy_ = bfhi(ow_.x), oz_ = bflo(ow_.y), ow2_ = bfhi(ow_.y); \
            float ss_ = (ox_ * ox_ + oy_ * oy_) + (oz_ * oz_ + ow2_ * ow2_); ss_ += __shfl_xor(ss_, 1); ss_ += __shfl_xor(ss_, 2); ss_ += __shfl_xor(ss_, 4); ss_ += __shfl_xor(ss_, 8); \
            const float rs_ = 1.0f / sqrtf(ss_ * (1.f / 64.f) + 1e-6f); const size_t row_ = (size_t)rowbase + 64 * (nc) + t_; \
            const v2u z_ = *(const LAS v2u*)(bz_ + t_ * 128 + c4_ * 2); v2u w_; \
            w_.x = pk2(ox_ * rs_ * gbo.x * bflo(z_.x), oy_ * rs_ * gbo.y * bfhi(z_.x)); w_.y = pk2(oz_ * rs_ * gbo.z * bflo(z_.y), ow2_ * rs_ * gbo.w * bfhi(z_.y)); \
            *(v2u*)(CAT + row_ * D + WA + h * HD + c4_) = w_; } } while (0)
    LAS float* gls = (LAS float*)(lds + MISC_OFF + 1024);
    if (tid < NCH) gls[tid] = GLarr[bh * NCH + tid];
    const f32x4 gbo = *(const f32x4*)(g_b_out + 4 * (lane & 15));
    if (wid >= 4) { SCAN_BZDMA(0); SCAN_BZDMA(1); }
    SCAN_DMA(0, 0); SCAN_DMA(1, 1);
    SCAN_SYNC();
    const int swz = (fr >> 1) & 7;
    f32x4 S[4]; bf16x8 Sb[2];
#pragma unroll
    for (int mt = 0; mt < 4; ++mt) S[mt] = (f32x4){0.f, 0.f, 0.f, 0.f};
    Sb[0] = (bf16x8){0, 0, 0, 0, 0, 0, 0, 0}; Sb[1] = Sb[0];
    int slot = 0;
    for (int n = 0; n < NCH; ++n) {
        if (wid >= 4 && n > 0) { SCAN_POST(n - 1); asm volatile("s_waitcnt lgkmcnt(0)" ::: "memory"); if (n + 1 < NCH) SCAN_BZDMA(n + 1); }
        if (n + 2 < NCH) { const int s2 = (slot == 0) ? 2 : slot - 1; SCAN_DMA(n + 2, s2); }
        if (wid < 4) {
            const LAS unsigned char* base = lds + slot * 40960;
            const float gL = gls[n];
            const f32x4 z4 = (f32x4){0.f, 0.f, 0.f, 0.f};
            f32x4 U[4], O[4];
            const int c0 = (fq ^ swz) << 4, c1 = ((4 + fq) ^ swz) << 4;
#pragma unroll
            for (int mt = 0; mt < 4; ++mt) { const LAS unsigned char* rp = base + (16 * mt + fr) * 128;
                f32x4 P = MFMA16(*(const LAS bf16x8*)(rp + c0), Sb[0], z4); P = MFMA16(*(const LAS bf16x8*)(rp + c1), Sb[1], P);
                const v2u uv = *(const LAS v2u*)(base + 8192 + (e0 + fr) * 128 + (((4 * (mt >> 1) + fq) ^ (((e0 + fr) >> 1) & 7)) << 4) + (mt & 1) * 8);
                U[mt][0] = bflo(uv.x) - P[0]; U[mt][1] = bfhi(uv.x) - P[1]; U[mt][2] = bflo(uv.y) - P[2]; U[mt][3] = bfhi(uv.y) - P[3]; }
            bf16x8 Ub[2]; Ub[0] = pack8(U[0], U[1]); Ub[1] = pack8(U[2], U[3]);
#pragma unroll
            for (int mt = 0; mt < 4; ++mt) { const LAS unsigned char* rq = base + 16384 + (16 * mt + fr) * 128; const LAS unsigned char* rk = rq + 8192;
                f32x4 o = MFMA16(*(const LAS bf16x8*)(rq + c0), Sb[0], z4); o = MFMA16(*(const LAS bf16x8*)(rq + c1), Sb[1], o);
                o = MFMA16(*(const LAS bf16x8*)(rk + c0), Ub[0], o); o = MFMA16(*(const LAS bf16x8*)(rk + c1), Ub[1], o); O[mt] = o; }
#pragma unroll
            for (int mt = 0; mt < 4; ++mt) { const LAS unsigned char* rd = base + 32768 + (16 * mt + fr) * 128;
                f32x4 s = S[mt] * gL; s = MFMA16(*(const LAS bf16x8*)(rd + c0), Ub[0], s); s = MFMA16(*(const LAS bf16x8*)(rd + c1), Ub[1], s); S[mt] = s; }
            MFMA_SETTLE4(S[0], S[1], S[2], S[3]);
            Sb[0] = pack8(S[0], S[1]); Sb[1] = pack8(S[2], S[3]);
            LAS bf16* ob = obuf + (n & 1) * 4096;
            MFMA_SETTLE4(O[0], O[1], O[2], O[3]);
#pragma unroll
            for (int mt = 0; mt < 4; ++mt)
#pragma unroll
                for (int r = 0; r < 4; ++r) ob[(16 * mt + 4 * fq + r) * 64 + e0 + fr] = f2bf(O[mt][r]);
        }
        if (n + 2 < NCH) SCAN_SYNC5(); else SCAN_SYNC();
        slot = (slot == 2) ? 0 : slot + 1;
    }
    if (wid >= 4) { SCAN_POST(NCH - 1); }
    else {
#pragma unroll
        for (int mt = 0; mt < 4; ++mt)
#pragma unroll
            for (int r = 0; r < 4; ++r) out_S[((size_t)bh * 64 + 16 * mt + 4 * fq + r) * 64 + e0 + fr] = S[mt][r];
    }
    SCAN_SYNC();
#undef SCAN_DMA
#undef SCAN_SYNC
#undef SCAN_SYNC5
#undef SCAN_POST
#undef SCAN_BZDMA
}
__device__ __noinline__ void xcd_barrier_call(unsigned* bar, unsigned x, volatile LAS unsigned* st) { XcdBarrier b; b.bar = bar; b.x = x; b.st = st; xcd_barrier(b); }

struct OneUnit { int pm, pn;
    __device__ __forceinline__ bool next(int i, pg8::Unit& u) const { if (i) return false; u.pm = pm; u.pn = pn; return true; }
    __device__ __forceinline__ void a_ready(const pg8::Unit&) const {}
    __device__ __forceinline__ void done(const pg8::Unit&) const {} };
constexpr int NTAIL = 8, CW_TAIL = 98304;
DI void tail_meet(unsigned* cnt, int tid0, int target = NTAIL) {
    VM_WAIT(); __syncthreads();
    if (tid0 == 0) { __builtin_amdgcn_fence(__ATOMIC_RELEASE, "agent"); VM_WAIT(); __hip_atomic_fetch_add(cnt, 1u, RLX_AGENT);
        for (unsigned sp = 0; sp < (1u << 22); ++sp) { if (__hip_atomic_load(cnt, RLX_AGENT) >= (unsigned)target) break; __builtin_amdgcn_s_sleep(2); }
        __builtin_amdgcn_fence(__ATOMIC_ACQUIRE, "agent"); VM_WAIT(); }
    __syncthreads();
}
DI void tail_arrive(unsigned* cnt, int tid0) {
    VM_WAIT(); __syncthreads();
    if (tid0 == 0) { __builtin_amdgcn_fence(__ATOMIC_RELEASE, "agent"); VM_WAIT(); __hip_atomic_fetch_add(cnt, 1u, RLX_AGENT); }
}
DI void tail_wait(unsigned* cnt, int tid0, int target) {
    if (tid0 == 0) { for (unsigned sp = 0; sp < (1u << 22); ++sp) { if (__hip_atomic_load(cnt, RLX_AGENT) >= (unsigned)target) break; __builtin_amdgcn_s_sleep(2); }
        __builtin_amdgcn_fence(__ATOMIC_ACQUIRE, "agent"); VM_WAIT(); }
    __syncthreads();
}
struct Args { const float* in[26]; float* out; unsigned char* ws; int ph_lo, ph_hi; };
template <int PHASE_MASK, int UNIT_MASK> __global__ void __launch_bounds__(NWAVES * 64, 2) fwd_kernel(Args args) {
    extern __shared__ __attribute__((aligned(16))) unsigned char lds_raw[];
    LAS unsigned char* lds = (LAS unsigned char*)lds_raw;
    volatile LAS unsigned* MISC = (volatile LAS unsigned*)(lds + MISC_OFF);
    const int tid0 = threadIdx.x, wid = __builtin_amdgcn_readfirstlane(tid0 >> 6);
    const int G = gridDim.x, bx = blockIdx.x, vcu = (G % 8 == 0) ? (bx % 8) * (G / 8) + bx / 8 : bx;
    const int gw = vcu * NWAVES + wid, NGW = G * NWAVES;
    typedef const __attribute__((address_space(4))) Args* kargs_t;
    const kargs_t kargs = (kargs_t)__builtin_amdgcn_kernarg_segment_ptr();
#define PH_BEGIN() kargs_t A = kargs; int tid = tid0; asm volatile("" : "+s"(A), "+v"(tid)); const int lane = tid & 63; unsigned char* const ws = A->ws; float* const out = A->out; (void)ws; (void)out; (void)lane
#define WSP(T, off) ((T*)(ws + (off)))
    const int lo = args.ph_lo, hi = args.ph_hi;
    for (int u = tid0; u < (LDS_BYTES - MISC_OFF) / 4; u += NWAVES * 64) ((LAS unsigned*)(lds + MISC_OFF))[u] = 0u;
    __syncthreads();
    XcdBarrier bar; bar.bar = (unsigned*)(args.ws + WS_CTL) + CW_BAR + lo * XCD_BAR_WORDS; bar.x = xb_xcc_id(); bar.st = nullptr;
    if (hi - lo > 1) bar = xcd_barrier_post((unsigned*)(args.ws + WS_CTL) + CW_BAR + lo * XCD_BAR_WORDS, MISC + 8);
#define UM(i) ((UNIT_MASK >> (i)) & 1)
#ifndef DUP_MASK
#define DUP_MASK 0
#endif
#ifndef PREP_FN
#define PREP_FN prep_unit2
#endif
#ifndef PROBE_SKIP
#define PROBE_SKIP 0
#endif
#ifndef DUP_UNITS
#define DUP_UNITS 0xff
#endif
#define UMR(i) (UM(i) && (rep == 0 || ((DUP_UNITS >> (i)) & 1)))
#define NREP(kind) (((DUP_MASK >> (kind)) & 1) ? 2 : 1)
#define KIND(k) ((k) == 0 ? 0 : ((k) - 1) % 9 + 1)
#define IN(k) (((PHASE_MASK >> KIND(k)) & 1) && lo <= (k) && (k) < hi)
#define SEAM(k) do { if (IN(k) && IN((k) + 1)) xcd_barrier_call(bar.bar, bar.x, bar.st); } while (0)
#define YROW(m) ((m) < MP ? out + O_YP + (size_t)(m) * D : out + O_YS + (size_t)((m) - MP) * D)
#define XROW(m) ((m) < MP ? A->in[0] + (size_t)(m) * D : A->in[1] + (size_t)((m) - MP) * D)

    if (IN(0)) { PH_BEGIN();
        bf16* WTIN = WSP(bf16, WS_WIN); bf16* WTOUT = WSP(bf16, WS_WOUT); bf16* WTF1 = WSP(bf16, WS_WF1); bf16* WTF2 = WSP(bf16, WS_WF2); bf16* WSG = WSP(bf16, WS_WSG); bf16* H = WSP(bf16, WS_H);
        LAS float* scr = (LAS float*)(lds + wid * 16384);
#pragma unroll 1
        for (int pass = 0; pass < 2; ++pass) {
        if (((pass ^ wid) & 1) == 0) {
        for (int it = gw; it < 12800; it += NGW) { const int l = it / 6400, r = it % 6400;
            if (r < 1664) p0_transpose_item<1>(A->in[8] + (size_t)l * D * DIN, D, DIN, NIN / 32, WTIN + (size_t)l * NIN * D, scr, r, lane);
            else if (r < 2176) p0_transpose_item<0>(A->in[20] + (size_t)l * D * D, D, D, D / 32, WTOUT + (size_t)l * D * D, scr, r - 1664, lane, A->in[14] + l * WA, WA);
            else if (r < 4992) p0_transpose_item<2>(A->in[23] + (size_t)l * D * NF1, D, NF1, NF1 / 32, WTF1 + (size_t)l * NF1 * D, scr, r - 2176, lane);
            else p0_transpose_item<0>(A->in[24] + (size_t)l * DFF * D, DFF, D, D / 32, WTF2 + (size_t)l * D * DFF, scr, r - 4992, lane); }
        } else
        for (int m = gw; m < M; m += 4 * NGW) rms_rows_to_bf16<4>(m, NGW, M, RowsF32Split{A->in[0], A->in[1]}, A->in[7], H, lane);
        }
        for (int i = bx * NWAVES * 64 + tid; i < 2 * 4 * 128 * 128; i += G * NWAVES * 64) { const int ii = (i >> 7) & 127, j = i & 127; WSG[i] = ((j >> 6) <= (ii >> 6)) ? f2bf(A->in[17][i]) : (bf16)0; }
    }
    SEAM(0);

    for (int l = 0; l < 2; ++l) {
        const int pb = 1 + 9 * l;
        for (int rep = 0; rep < NREP(1); ++rep) { if (rep) xcd_barrier_call(bar.bar, bar.x, bar.st);
        if (IN(pb)) { PH_BEGIN();
            bf16* H = WSP(bf16, WS_H); bf16* WTIN = WSP(bf16, WS_WIN);
            pg8::Gemm g{H, WTIN + (size_t)l * NIN * D, M, NIN, D}; pg8::StaticOrder S; S.init(M, NIN, G, bx);
            pg8::EpiIn E{WSP(bf16, WS_Q), WSP(bf16, WS_K), WSP(bf16, WS_V), WSP(bf16, WS_BQKV), WSP(bf16, WS_BZ), WSP(bf16, WS_CU), WSP(bf16, WS_CV), WSP(float, WS_SM), out + O_KP + (size_t)l * MP * WA, out + O_VP + (size_t)l * MP * WA, out + O_KS + (size_t)l * MS * WA, out + O_VS + (size_t)l * MS * WA, MP, QSCALE};
            pg8::gemm_phase<pg8::EpiIn, pg8::StaticOrder, true, true>(lds, g, S, E);
        }
        }
        SEAM(pb);
        for (int rep = 0; rep < NREP(2); ++rep) { if (rep) xcd_barrier_call(bar.bar, bar.x, bar.st);
        if (IN(pb + 1)) {
            if (UMR(1)) for (int u = bx; u < 48; u += G) { PH_BEGIN(); cumsum_unit(u, WSP(float, WS_SM), A->in[9] + l * NHA, out + O_LFP + (size_t)l * MP * NHA, WSP(float, WS_CL), lds, tid, lane, wid); }
            {
                LAS unsigned char* L = lds + wid * PREP_WAVE_LDS;
                if (UMR(5)) for (int u = vcu * NWAVES + wid; u < 6144; u += G * NWAVES) { PH_BEGIN(); PREP_FN(u, WSP(bf16, WS_BQKV), WSP(float, WS_SM), A->in[11] + l * NHB, A->in[12] + l * NHB, A->in[10] + (size_t)l * 4 * 1152, ws + WS_PREP, WSP(float, WS_GL), out + O_CVP + (size_t)l * NB * 3 * 1152, L, lane); }
            }
        }
        }
        SEAM(pb + 1);
#define QPOP(q) ({ if (tid0 == 0) { PH_BEGIN(); MISC[0] = __hip_atomic_fetch_add(WSP(unsigned, WS_CTL) + CW_QUEUE + 64 * (32 * l + 16 * rep + (q)), 1u, RLX_AGENT); } LDS_WAIT(); __syncthreads(); const int it_ = __builtin_amdgcn_readfirstlane((int)MISC[0]); __syncthreads(); it_; })
        for (int rep = 0; rep < NREP(3); ++rep) { if (rep) xcd_barrier_call(bar.bar, bar.x, bar.st);
        if (IN(pb + 2)) {
            if (UMR(6)) for (int u = bx; u < 48; u += G) { PH_BEGIN(); scan_unit(u, ws + WS_PREP, WSP(float, WS_GL), WSP(bf16, WS_BZ), A->in[13] + l * HD, WSP(bf16, WS_CAT), out + O_SP + (size_t)l * NB * NHB * 4096, lds, tid, lane, wid); }
            if (UMR(0)) for (;;) { const int item = QPOP(0) + 192; if (item >= 192 + 24) break;
                if (item >= 192) { PH_BEGIN(); const int u = (item - 192) * NWAVES + wid; LAS unsigned char* L = lds + wid * PREP_WAVE_LDS;
                    sgdn_unit(u / NHB, u % NHB, WSP(bf16, WS_BQKV), WSP(float, WS_SM), A->in[11][l * NHB + u % NHB], A->in[12][l * NHB + u % NHB], A->in[10] + (size_t)l * 4 * 1152,
                              A->in[5] + (size_t)l * DB * 3 * 1152, A->in[6] + (size_t)l * DB * NHB * 4096, WSP(bf16, WS_BZ), A->in[13] + l * HD, WSP(bf16, WS_CAT),
                              out + O_CVS + (size_t)l * DB * 3 * 1152, out + O_SS + (size_t)l * DB * NHB * 4096, L, lane);
                    LDS_WAIT(); __syncthreads(); }
 }
            if (UMR(7)) for (int xo = 0; xo < 8; ++xo) { const int xq = (int)((bar.x + (unsigned)xo) & 7u);
              for (;;) { const int qi = QPOP(8 + xq); if (qi >= 216) break;
                if (qi % 9 == 8) { PH_BEGIN(); const int su = 24 * xq + qi / 9;
                    sattn_unit(su / NHA, su % NHA, WSP(bf16, WS_Q), WSP(bf16, WS_K), WSP(bf16, WS_V), WSP(float, WS_SM), A->in[9] + l * NHA, out + O_LFS + (size_t)l * MS * NHA,
                               A->in[2] + (size_t)l * DB * PAST * WA, A->in[3] + (size_t)l * DB * PAST * WA, A->in[4] + (size_t)l * DB * PAST * NHA, WSP(bf16, WS_CAT), WSP(float, WS_SSQ), lds, tid, lane, wid); continue; }
                const int item = qi - qi / 9;
                { PH_BEGIN(); const int qb = 31 - item / 6, bh = 6 * xq + item % 6;
                  attn_body::attn_unit<40>(bh / NHA, bh % NHA, qb, WSP(const attn_body::bf16, WS_Q), WSP(const attn_body::bf16, WS_K), WSP(const attn_body::bf16, WS_V), WSP(attn_body::bf16, WS_CAT), WSP(float, WS_CL) + (size_t)bh * SEQ, (char*)lds_raw, WSP(float, WS_SSQ)); } } }
            if (UMR(2)) for (;;) { const int item = QPOP(2); if (item >= 544) break;
                if (item < 512) { PH_BEGIN(); sgate_unit(item, WSP(bf16, WS_CU), WSP(bf16, WS_CV), WSP(bf16, WS_WSG) + (size_t)l * 4 * 128 * 128, A->in[15] + l * WC, A->in[16] + l * WC, A->in[18] + l * 4 * 128, A->in[19] + l * WC, WSP(bf16, WS_CAT), lds, tid, lane, wid); }
                else { PH_BEGIN(); sgate_sample_unit(item - 512, WSP(bf16, WS_CU), WSP(bf16, WS_CV), A->in[17] + (size_t)l * 4 * 128 * 128, A->in[15] + l * WC, A->in[16] + l * WC, A->in[18] + l * 4 * 128, A->in[19] + l * WC, WSP(bf16, WS_CAT),
                                                out + O_CS + (size_t)l * MS * WC, lds, tid); } }
        }
        }
        SEAM(pb + 2);
        for (int rep = 0; rep < NREP(5); ++rep) { if (rep) xcd_barrier_call(bar.bar, bar.x, bar.st);
        if (IN(pb + 4)) { PH_BEGIN(); bf16* CAT = WSP(bf16, WS_CAT); bf16* WTOUT = WSP(bf16, WS_WOUT); bf16* M1 = WSP(bf16, WS_M1);
            pg8::Gemm g{CAT, WTOUT + (size_t)l * D * D, MP, D, D, 0, WSP(float, WS_SSQ)}; pg8::StaticOrder S; S.init(MP, D, G, bx); pg8::EpiPlain E{M1, D};
            pg8::gemm_phase<pg8::EpiPlain, pg8::StaticOrder, true, true, true>(lds, g, S, E);
        }
        }
        SEAM(pb + 4);
        if (IN(pb + 5)) { PH_BEGIN(); int bxp = bx; asm volatile("" : "+s"(bxp));
            bf16* M1 = WSP(bf16, WS_M1); bf16* H = WSP(bf16, WS_H);
            bf16* XR = WSP(bf16, WS_XR);
            const RowsBf16 xr_of{XR};
            constexpr int NF1S = 2 * (NF1 / 256), R1 = 47616; static_assert(R1 % ((256 - NTAIL) * NWAVES) == 0 && R1 < MP, "row split");
            unsigned* cnt2 = WSP(unsigned, WS_CTL) + CW_TAIL + 64 * (4 + l);
            const bool tailwg = bxp < NTAIL, fwg = !tailwg && bxp < NTAIL + NF1S;
            if (tailwg) {
                bf16* CAT = WSP(bf16, WS_CAT); bf16* WTOUT = WSP(bf16, WS_WOUT);
                pg8::Gemm g{CAT + (size_t)MP * D, WTOUT + (size_t)l * D * D, MS, D, D, 0, WSP(float, WS_SSQ) + (size_t)MP * 8}; OneUnit S{bxp >> 2, bxp & 3}; pg8::EpiPlain E{M1 + (size_t)MP * D, D};
                pg8::gemm_phase<pg8::EpiPlain, OneUnit, true, true, true>(lds, g, S, E);
                tail_meet(WSP(unsigned, WS_CTL) + CW_TAIL + 64 * (2 * l), tid0);
            }
#pragma unroll 1
            for (int rg = 0; rg < 2; ++rg) { int r0, rstride, rend;
                if (tailwg) { r0 = MP + bxp * NWAVES + wid; rstride = NTAIL * NWAVES; rend = rg ? 0 : M; }
                else if (rg == 0) { r0 = (bxp - NTAIL) * NWAVES + wid; rstride = (G - NTAIL) * NWAVES; rend = R1; }
                else { r0 = R1 + (bxp - NTAIL - NF1S) * NWAVES + wid; rstride = (G - NTAIL - NF1S) * NWAVES; rend = fwg ? 0 : MP; }
                if (l == 0) { for (int m = r0; m < rend; m += 2 * rstride) norm_res_rows<true, false, 2>(m, rstride, rend, M1, RowsF32Split{A->in[0], A->in[1]}, xr_of, A->in[21] + l * D, A->in[22] + l * D, H, lane); }
                else { for (int m = r0; m < rend; m += 4 * rstride) norm_res_rows<false, false, 4>(m, rstride, rend, M1, xr_of, xr_of, A->in[21] + l * D, A->in[22] + l * D, H, lane); }
            }
            if (tailwg) tail_arrive(cnt2, tid0);
            if (fwg) { tail_wait(cnt2, tid0, NTAIL);
                bf16* WTF1 = WSP(bf16, WS_WF1); bf16* ACT = WSP(bf16, WS_ACT); const int fu = bxp - NTAIL;
                pg8::Gemm g{H, WTF1 + (size_t)l * NF1 * D, M, NF1, D}; OneUnit S{MP / 256 + fu / (NF1 / 256), fu % (NF1 / 256)}; pg8::EpiSwiglu E{ACT, DFF};
                pg8::gemm_phase<pg8::EpiSwiglu, OneUnit, true, true>(lds, g, S, E); }
        }
        SEAM(pb + 5);
        for (int rep = 0; rep < NREP(7); ++rep) { if (rep) xcd_barrier_call(bar.bar, bar.x, bar.st);
        if (IN(pb + 6)) { PH_BEGIN(); bf16* H = WSP(bf16, WS_H); bf16* WTF1 = WSP(bf16, WS_WF1); bf16* ACT = WSP(bf16, WS_ACT);
            pg8::Gemm g{H, WTF1 + (size_t)l * NF1 * D, MP, NF1, D}; pg8::StaticOrder S; S.init(MP, NF1, G, bx); pg8::EpiSwiglu E{ACT, DFF};
            pg8::gemm_phase<pg8::EpiSwiglu, pg8::StaticOrder, true, true>(lds, g, S, E);
        }
        }
        SEAM(pb + 6);
        for (int rep = 0; rep < NREP(8); ++rep) { if (rep) xcd_barrier_call(bar.bar, bar.x, bar.st);
        if (IN(pb + 7)) { PH_BEGIN(); bf16* ACT = WSP(bf16, WS_ACT); bf16* WTF2 = WSP(bf16, WS_WF2); bf16* M2 = WSP(bf16, WS_M2);
            pg8::Gemm g{ACT, WTF2 + (size_t)l * D * DFF, MP, D, DFF}; pg8::StaticOrder S; S.init(MP, D, G, bx); pg8::EpiPlain E{M2, D};
            pg8::gemm_phase<pg8::EpiPlain, pg8::StaticOrder, true, true>(lds, g, S, E);
        }
        }
        SEAM(pb + 7);
        if (IN(pb + 8)) { PH_BEGIN(); int bxp = bx; asm volatile("" : "+s"(bxp));
            bf16* M2 = WSP(bf16, WS_M2); bf16* H = WSP(bf16, WS_H);
            bf16* XR = WSP(bf16, WS_XR);
            const RowsBf16 xr_of{XR};
            constexpr int NT2 = 2 * NTAIL;
            if (G > NT2 && bxp < NT2) {
                bf16* ACT = WSP(bf16, WS_ACT); bf16* WTF2 = WSP(bf16, WS_WF2); float* PART = WSP(float, WS_PART);
                const int un = bxp & (NTAIL - 1), kh = bxp / NTAIL;
                pg8::Gemm g{ACT + (size_t)MP * DFF + kh * (DFF / 2), WTF2 + (size_t)l * D * DFF + kh * (DFF / 2), MS, D, DFF / 2, DFF}; OneUnit S{un >> 2, un & 3}; pg8::EpiF32 E{PART + (size_t)kh * MS * D, D};
                pg8::gemm_phase<pg8::EpiF32, OneUnit, true, true>(lds, g, S, E);
                tail_meet(WSP(unsigned, WS_CTL) + CW_TAIL + 64 * (2 * l + 1), tid0, NT2);
                const PairF32 m2s{PART, PART + (size_t)MS * D};
                const int r0 = MP + bxp * NWAVES + wid, rstride = NT2 * NWAVES;
                if (l == 0) { for (int m = r0; m < M; m += 2 * rstride) norm_res_rows<false, false, 2>(m, rstride, M, m2s, xr_of, xr_of, A->in[25] + l * D, A->in[7] + D, H, lane); }
                else { for (int m = r0; m < M; m += 2 * rstride) norm_res_rows<false, true, 2>(m, rstride, M, m2s, xr_of, RowsF32Split{out + O_YP, out + O_YS}, A->in[25] + l * D, (const float*)nullptr, H, lane); }
            } else {
                const int r0 = (bxp - NT2) * NWAVES + wid, rstride = (G - NT2) * NWAVES, rend = MP;
                if (l == 0) { for (int m = r0; m < rend; m += 4 * rstride) norm_res_rows<false, false, 4>(m, rstride, rend, M2, xr_of, xr_of, A->in[25] + l * D, A->in[7] + D, H, lane); }
                else { for (int m = r0; m < rend; m += 4 * rstride) norm_res_rows<false, true, 4>(m, rstride, rend, M2, xr_of, RowsF32Split{out + O_YP, out + O_YS}, A->in[25] + l * D, (const float*)nullptr, H, lane); }
            }
        }
        SEAM(pb + 8);
    }
#undef IN
#undef SEAM
}

#ifndef MK_PER_PHASE
#define MK_PER_PHASE 0
#endif
typedef void (*kern_t)(Args);
static void launch_one(kern_t k, int grid, Args a, int p, hipStream_t stream) {
    a.ph_lo = p; a.ph_hi = p + 1;
    hipLaunchKernelGGL(k, dim3(grid), dim3(NWAVES * 64), LDS_BYTES, stream, a);
}
extern "C" void kernel_launch(void* const* d_in, const int* in_sizes, int n_in, void* d_out, int out_size, void* d_ws, size_t ws_size, hipStream_t stream) {
    static int grid = 0;
#if MK_PER_PHASE
    static const kern_t kerns[] = { fwd_kernel<0x001, 0xff>, fwd_kernel<0x002, 0xff>, fwd_kernel<0x004, 0x02>, fwd_kernel<0x004, 0x10>, fwd_kernel<0x004, 0x20>,
                                    fwd_kernel<0x008, 0x40>, fwd_kernel<0x008, 0x01>, fwd_kernel<0x008, 0x80>, fwd_kernel<0x008, 0x04>, fwd_kernel<0x010, 0xff>, fwd_kernel<0x020, 0xff>, fwd_kernel<0x040, 0xff>, fwd_kernel<0x080, 0xff>, fwd_kernel<0x100, 0xff>, fwd_kernel<0x200, 0xff> };
    static const int kphase[] = { 0, 1, 2, 2, 2, 3, 3, 3, 3, 4, 5, 6, 7, 8, 9 };
    constexpr int NK = sizeof(kphase) / sizeof(int);
#else
    static const kern_t kerns[] = { fwd_kernel<0x3ff, 0xff> };
    constexpr int NK = 1;
#endif
    if (grid == 0) {
        if (n_in != 26 || (size_t)out_size != O_END || ws_size < WS_END) { fprintf(stderr, "kernel_launch: built for 26 inputs, %zu outputs, >= %zu bytes of workspace; got n_in %d, out %d, ws %zu; nothing launched\n", (size_t)O_END, (size_t)WS_END, n_in, out_size, ws_size); grid = -1; return; }
        int dev = 0, cus = 0;
        if (hipGetDevice(&dev) != hipSuccess || hipDeviceGetAttribute(&cus, hipDeviceAttributeMultiprocessorCount, dev) != hipSuccess) { fprintf(stderr, "kernel_launch: device query failed\n"); grid = -1; return; }
        for (int i = 0; i < NK; ++i)
            if (hipFuncSetAttribute((const void*)kerns[i], hipFuncAttributeMaxDynamicSharedMemorySize, LDS_BYTES) != hipSuccess) { fprintf(stderr, "kernel_launch: hipFuncSetAttribute(%d B LDS) failed for kernel %d\n", LDS_BYTES, i); grid = -1; return; }
        (void)hipGetLastError();
        grid = cus;
    }
    if (grid < 0) return;
    if (hipMemsetAsync((char*)d_ws + WS_CTL, 0, CTL_ZERO_BYTES, stream) != hipSuccess) { fprintf(stderr, "kernel_launch: memset failed\n"); return; }
    Args a{};
    for (int i = 0; i < 26; ++i) a.in[i] = (const float*)d_in[i];
    a.out = (float*)d_out; a.ws = (unsigned char*)d_ws;
#if MK_PER_PHASE
    launch_one(kerns[0], grid, a, 0, stream);
    for (int l = 0; l < 2; ++l) for (int i = 1; i < NK; ++i) launch_one(kerns[i], grid, a, 9 * l + kphase[i], stream);
#elif defined(MK_CUTS)
    { static const int cuts[] = {MK_CUTS}; constexpr int NC = sizeof(cuts) / sizeof(int); for (int i = 0; i + 1 < NC; ++i) { a.ph_lo = cuts[i]; a.ph_hi = cuts[i + 1]; hipLaunchKernelGGL(kerns[0], dim3(grid), dim3(NWAVES * 64), LDS_BYTES, stream, a); } }
#else
    a.ph_lo = 0; a.ph_hi = N_PHASES;
    hipLaunchKernelGGL(kerns[0], dim3(grid), dim3(NWAVES * 64), LDS_BYTES, stream, a);
#endif
    const hipError_t le = hipPeekAtLastError();
    if (le != hipSuccess) fprintf(stderr, "kernel_launch: launch failed: %s\n", hipGetErrorName(le));
}
```

```cpp
#include <hip/hip_runtime.h>
#include <cstdio>
#include <cstdint>
namespace pg8 {
#define PG8_LAS __attribute__((address_space(3)))
typedef unsigned short bf16_t;
typedef short bf16x8 __attribute__((ext_vector_type(8)));
typedef float f32x4 __attribute__((ext_vector_type(4)));
typedef unsigned u32x4 __attribute__((ext_vector_type(4)));
constexpr int BM = 256, BK = 64, HALF = 128, HTB = HALF * BK * 2  , STAGE_BYTES = 8 * HTB, NXCD = 8, WGM = 8;

__host__ __device__ __forceinline__ int lds_byte(int r, int c) { const int st = (r >> 4) * 2 + (c >> 5), rr = r & 15, cc = c & 31, ob = rr * 64 + cc * 2; return st * 1024 + (ob ^ (((ob >> 9) & 1) << 5)); }
__host__ __device__ __forceinline__ void stage_rc(int b, int& R, int& C) { const int st = b / 1024, sb = b % 1024, swz = sb ^ (((sb >> 9) & 1) << 5); R = (st >> 1) * 16 + swz / 64; C = (st & 1) * 32 + (swz % 64) / 2; }
__host__ __device__ __forceinline__ int perm32(int rho) { const int n = rho >> 4, i = rho & 15; return 8 * (i >> 2) + 4 * n + (i & 3); }

struct Unit { int pm, pn; };
struct Gemm { const bf16_t* A; const bf16_t* Bt; int M, N, K; int ld; const float* ssq; };

struct StaticOrder {
    int nM, nN, nwg, G, c;
    __host__ __device__ void init(int M, int N, int G_, int c_) { nM = M / BM; nN = N / BM; nwg = nM * nN; G = G_; c = c_; }
    __host__ __device__ bool next(int i, Unit& u) const {
        const long L = (long)i * G + c; if (L >= nwg) return false;
        int wgid = (int)L; { const int q = nwg / NXCD, r = nwg % NXCD, xcd = wgid % NXCD, off = wgid / NXCD; wgid = (xcd < r ? xcd * (q + 1) : r * (q + 1) + (xcd - r) * q) + off; }
        const int nig = WGM * nN, gid = wgid / nig, fm = gid * WGM, gsz = (nM - fm) < WGM ? (nM - fm) : WGM;
        u.pm = fm + ((wgid % nig) % gsz); u.pn = (wgid % nig) / gsz; return true;
    }
    __device__ __forceinline__ void a_ready(const Unit&) const {}
    __device__ __forceinline__ void done(const Unit&) const {}
};

__device__ __forceinline__ unsigned cvt_pk_bf16(float lo, float hi) { unsigned r; asm volatile("v_cvt_pk_bf16_f32 %0, %1, %2" : "=v"(r) : "v"(lo), "v"(hi)); return r; }
#define MFMA_SETTLE4(a, b, c, d) asm volatile("s_nop 15\n\ts_nop 7" : "+v"(a), "+v"(b), "+v"(c), "+v"(d))
typedef float f32x2 __attribute__((ext_vector_type(2)));
typedef float f32x4e __attribute__((ext_vector_type(4)));
__device__ __forceinline__ float silu_f(float x) { return x * __builtin_amdgcn_rcpf(1.f + __builtin_amdgcn_exp2f(-1.4426950408889634f * x)); }
__device__ __forceinline__ float gelu_tanh_f(float x) { const float u2 = 1.5957691216057308f * (x + 0.044715f * x * x * x); return x * __builtin_amdgcn_rcpf(1.f + __builtin_amdgcn_exp2f(-1.4426950408889634f * u2)); }
__device__ __forceinline__ float softplus_f(float x) { return fmaxf(x, 0.f) + log1pf(__expf(-fabsf(x))); }
struct EpiPlain {
    static constexpr bool PERM = true, AFTER_DRAIN = false;
    bf16_t* O; int ldc;
    __device__ __forceinline__ void operator()(const f32x4 (&acc)[2][2][4][2], const Unit& u0, int wr, int wc, int fr, int fq) const {
        Unit u = u0; asm volatile("s_nop 15\n\ts_nop 7" : "+s"(u.pm), "+s"(u.pn));
        const int row0 = u.pm * BM + wr * 64 + fr, col0 = u.pn * BM + wc * 32 + 8 * fq;
#pragma unroll
        for (int ai = 0; ai < 2; ++ai)
#pragma unroll
            for (int m = 0; m < 4; ++m) { bf16_t* rowp = O + (size_t)(row0 + ai * HALF + m * 16) * ldc + col0;
#pragma unroll
                for (int bj = 0; bj < 2; ++bj) { const f32x4 v0 = acc[ai][bj][m][0], v1 = acc[ai][bj][m][1];
                    u32x4 w; w.x = cvt_pk_bf16(v0[0], v0[1]); w.y = cvt_pk_bf16(v0[2], v0[3]); w.z = cvt_pk_bf16(v1[0], v1[1]); w.w = cvt_pk_bf16(v1[2], v1[3]);
                    *(u32x4*)(rowp + bj * HALF) = w; } }
    }
};
struct EpiF32 {
    static constexpr bool PERM = true, AFTER_DRAIN = false;
    float* O; int ldc;
    __device__ __forceinline__ void operator()(const f32x4 (&acc)[2][2][4][2], const Unit& u0, int wr, int wc, int fr, int fq) const {
        Unit u = u0; asm volatile("" : "+s"(u.pm), "+s"(u.pn));
        const int row0 = u.pm * BM + wr * 64 + fr, col0 = u.pn * BM + wc * 32 + 8 * fq;
#pragma unroll
        for (int ai = 0; ai < 2; ++ai)
#pragma unroll
            for (int m = 0; m < 4; ++m) { float* rowp = O + (size_t)(row0 + ai * HALF + m * 16) * ldc + col0;
#pragma unroll
                for (int bj = 0; bj < 2; ++bj) { *(f32x4*)(rowp + bj * HALF) = acc[ai][bj][m][0]; *(f32x4*)(rowp + bj * HALF + 4) = acc[ai][bj][m][1]; } }
    }
};
struct EpiSwiglu {
    static constexpr bool PERM = true, AFTER_DRAIN = false;
    bf16_t* O; int ldc;
    __device__ __forceinline__ void operator()(const f32x4 (&acc)[2][2][4][2], const Unit& u0, int wr, int wc, int fr, int fq) const {
        Unit u = u0; asm volatile("" : "+s"(u.pm), "+s"(u.pn));
        const int row0 = u.pm * BM + wr * 64 + fr, col0 = u.pn * HALF + wc * 32 + 8 * fq;
#pragma unroll
        for (int ai = 0; ai < 2; ++ai)
#pragma unroll
            for (int m = 0; m < 4; ++m) { bf16_t* rowp = O + (size_t)(row0 + ai * HALF + m * 16) * ldc + col0;
                const f32x4 g0 = acc[ai][0][m][0], g1 = acc[ai][0][m][1], u0 = acc[ai][1][m][0], u1 = acc[ai][1][m][1];
                u32x4 w; w.x = cvt_pk_bf16(silu_f(g0[0]) * u0[0], silu_f(g0[1]) * u0[1]); w.y = cvt_pk_bf16(silu_f(g0[2]) * u0[2], silu_f(g0[3]) * u0[3]);
                w.z = cvt_pk_bf16(silu_f(g1[0]) * u1[0], silu_f(g1[1]) * u1[1]); w.w = cvt_pk_bf16(silu_f(g1[2]) * u1[2], silu_f(g1[3]) * u1[3]);
                *(u32x4*)rowp = w; }
    }
};
constexpr int SM_ROWS = 66048;
struct EpiIn {
    static constexpr bool PERM = true, AFTER_DRAIN = false;
    bf16_t *Q, *K, *V, *BQKV, *BZ, *CU, *CV; float* SM;
    float *okp, *ovp, *oks, *ovs;
    int mp; float qscale;
    template <int BJ> __device__ __forceinline__ void half(const f32x4 (&acc)[2][2][4][2], const Unit& u, int wr, int wc, int fr, int fq) const {
        const int rloc = wr * 64 + fr, c8 = wc * 32 + 8 * fq;
        const bool prompt = u.pm * BM < mp;
        const int hh = 2 * u.pn + BJ;
        int mode; bf16_t* dst; int ld; float* fdst = nullptr;
        if (hh < 3) { mode = 1; dst = Q + hh * 128; ld = 384; }
        else if (hh < 6) { mode = 2; dst = K + (hh - 3) * 128; ld = 384; fdst = (prompt ? okp : oks - (size_t)mp * 384) + (hh - 3) * 128; }
        else if (hh < 9) { mode = 2; dst = V + (hh - 6) * 128; ld = 384; fdst = (prompt ? ovp : ovs - (size_t)mp * 384) + (hh - 6) * 128; }
        else if (hh < 18) { mode = 0; dst = BQKV + (hh - 9) * 128; ld = 1152; }
        else if (hh < 21) { mode = 3; dst = BZ + (hh - 18) * 128; ld = 384; }
        else if (hh < 23) { mode = 4; dst = CU + (hh - 21) * 128; ld = 256; }
        else if (hh < 25) { mode = 4; dst = CV + (hh - 23) * 128; ld = 256; }
        else { mode = 5; dst = nullptr; ld = 0; }
        if (mode != 5) {
#pragma unroll
            for (int ai = 0; ai < 2; ++ai)
#pragma unroll
                for (int m = 0; m < 4; ++m) { const int row = u.pm * BM + ai * HALF + m * 16 + rloc;
                    f32x4 v0 = acc[ai][BJ][m][0], v1 = acc[ai][BJ][m][1];
                    if (mode == 2) { float* fp = fdst + (size_t)row * 384 + c8; *(f32x4*)fp = v0; *(f32x4*)(fp + 4) = v1; }
                    if (mode == 1) { v0 = v0 * qscale; v1 = v1 * qscale; }
                    if (mode == 3) {
#pragma unroll
                        for (int e = 0; e < 4; ++e) { v0[e] = silu_f(v0[e]); v1[e] = silu_f(v1[e]); } }
                    if (mode == 4) {
#pragma unroll
                        for (int e = 0; e < 4; ++e) { v0[e] = gelu_tanh_f(v0[e]); v1[e] = gelu_tanh_f(v1[e]); } }
                    u32x4 w; w.x = cvt_pk_bf16(v0[0], v0[1]); w.y = cvt_pk_bf16(v0[2], v0[3]); w.z = cvt_pk_bf16(v1[0], v1[1]); w.w = cvt_pk_bf16(v1[2], v1[3]);
                    *(u32x4*)(dst + (size_t)row * ld + c8) = w; }
        } else if (wc == 0 && fq < 3) {
#pragma unroll
            for (int ai = 0; ai < 2; ++ai)
#pragma unroll
                for (int m = 0; m < 4; ++m) { const int row = u.pm * BM + ai * HALF + m * 16 + rloc; float* sp = SM + (size_t)(8 * fq) * SM_ROWS + row; const f32x4 v0 = acc[ai][BJ][m][0], v1 = acc[ai][BJ][m][1];
                    sp[0] = v0[0]; sp[SM_ROWS] = v0[1]; sp[2 * (size_t)SM_ROWS] = v0[2]; sp[3 * (size_t)SM_ROWS] = v0[3]; sp[4 * (size_t)SM_ROWS] = v1[0]; sp[5 * (size_t)SM_ROWS] = v1[1]; sp[6 * (size_t)SM_ROWS] = v1[2]; sp[7 * (size_t)SM_ROWS] = v1[3]; }
        }
    }
    __device__ __forceinline__ void operator()(const f32x4 (&acc)[2][2][4][2], const Unit& u0, int wr, int wc, int fr, int fq) const {
        Unit u = u0; asm volatile("s_nop 15\n\ts_nop 7" : "+s"(u.pm), "+s"(u.pn));
        half<0>(acc, u, wr, wc, fr, fq); half<1>(acc, u, wr, wc, fr, fq); }
};

template <class Epi, class Sched, bool ALIGN_EPI = false, bool SP2 = false, bool RS = false>
__device__ __forceinline__ void gemm_phase(PG8_LAS unsigned char* lds, const Gemm g, const Sched& S, const Epi& E) {
    int tid = threadIdx.x; asm volatile("" : "+v"(tid));
    const int wid = __builtin_amdgcn_readfirstlane(tid >> 6), lane = tid & 63, wr = wid >> 2, wc = wid & 3, fr = lane & 15, fq = lane >> 4;
    const int K = g.K, nt = K / BK, LD = g.ld ? g.ld : g.K;
    unsigned voffA[2], voffB[2];
#pragma unroll
    for (int i = 0; i < 2; ++i) { int R, C; stage_rc(tid * 16 + i * 8192, R, C); const int Rb = Epi::PERM ? ((R & ~31) + perm32(R & 31)) : R;
        voffA[i] = (unsigned)(R * LD + C) * 2u; voffB[i] = (unsigned)(Rb * LD + C) * 2u; }
    const size_t kstep = (size_t)(BK * 2);
    const size_t hstep = (size_t)HALF * LD * 2;
    const size_t tstep = 2 * hstep;
    const unsigned ldsw = (unsigned)wid * 1024u;
    const int aoff = lds_byte(wr * 64 + fr, fq * 8), boff = lds_byte(wc * 32 + fr, fq * 8);
#define PG8_SA(b, h) (((b) * 2 + (h)) * HTB)
#define PG8_SB(b, h) ((4 + (b) * 2 + (h)) * HTB)
#define PG8_STAGE(bufoff, gbase, voff) do { _Pragma("unroll") for (int _i = 0; _i < 2; ++_i) \
        __builtin_amdgcn_global_load_lds((const unsigned*)((const char*)(gbase) + (voff)[_i]), (PG8_LAS unsigned*)(lds + (bufoff) + ldsw + _i * 8192), 16, 0, 0); } while (0)
#define PG8_LDA(dst, b, h) do { _Pragma("unroll") for (int m = 0; m < 4; ++m) _Pragma("unroll") for (int k = 0; k < 2; ++k) dst[m][k] = *(const PG8_LAS bf16x8*)(lds + PG8_SA(b, h) + aoff + m * 2048 + k * 1024); } while (0)
#define PG8_LDB(dst, b, h) do { _Pragma("unroll") for (int n = 0; n < 2; ++n) _Pragma("unroll") for (int k = 0; k < 2; ++k) dst[n][k] = *(const PG8_LAS bf16x8*)(lds + PG8_SB(b, h) + boff + n * 2048 + k * 1024); } while (0)
#define PG8_MMA(ai, bj, At, Bt) do { __builtin_amdgcn_s_setprio(1); _Pragma("unroll") for (int m = 0; m < 4; ++m) _Pragma("unroll") for (int n = 0; n < 2; ++n) _Pragma("unroll") for (int k = 0; k < 2; ++k) \
        acc[ai][bj][m][n] = __builtin_amdgcn_mfma_f32_16x16x32_bf16(Bt[n][k], At[m][k], acc[ai][bj][m][n], 0, 0, 0); __builtin_amdgcn_s_setprio(0); } while (0)
#define PG8_WAIT_V(n) asm volatile("s_waitcnt vmcnt(" #n ")" ::: "memory")
#define PG8_WAIT_L(n) asm volatile("s_waitcnt lgkmcnt(" #n ")" ::: "memory")
#define PG8_BAR __builtin_amdgcn_s_barrier()
#define PG8_SCHED __builtin_amdgcn_sched_barrier(0)
    Unit cur, nxt; int ui = 0;
    if (!S.next(0, cur)) return;
    f32x4 acc[2][2][4][2];
#pragma unroll
    for (int a = 0; a < 2; ++a)
#pragma unroll
        for (int b = 0; b < 2; ++b)
#pragma unroll
            for (int m = 0; m < 4; ++m)
#pragma unroll
                for (int n = 0; n < 2; ++n) acc[a][b][m][n] = (f32x4){0.f, 0.f, 0.f, 0.f};
    bf16x8 At[4][2], B0[2][2], B1[2][2]; f32x4 rsa, rsb;
    const char* cA = (const char*)g.A + (size_t)cur.pm * tstep; const char* cB = (const char*)g.Bt + (size_t)cur.pn * tstep;
    S.a_ready(cur);
    if constexpr (SP2) {
        PG8_STAGE(PG8_SB(0, 0), cB, voffB); PG8_STAGE(PG8_SB(0, 1), cB + hstep, voffB); PG8_STAGE(PG8_SA(0, 0), cA, voffA); PG8_STAGE(PG8_SA(0, 1), cA + hstep, voffA);
        if (wr == 1) PG8_BAR;
        PG8_WAIT_V(2); PG8_BAR;
        PG8_STAGE(PG8_SB(1, 0), cB + kstep, voffB); PG8_STAGE(PG8_SA(1, 0), cA + kstep, voffA); PG8_STAGE(PG8_SB(1, 1), cB + hstep + kstep, voffB);
        PG8_WAIT_V(6); PG8_BAR;
    } else {
        PG8_STAGE(PG8_SB(0, 0), cB, voffB); PG8_STAGE(PG8_SA(0, 0), cA, voffA); PG8_STAGE(PG8_SB(0, 1), cB + hstep, voffB); PG8_STAGE(PG8_SA(0, 1), cA + hstep, voffA);
        if (wr == 1) PG8_BAR;
        PG8_WAIT_V(4); PG8_BAR;
        PG8_STAGE(PG8_SB(1, 0), cB + kstep, voffB); PG8_STAGE(PG8_SA(1, 0), cA + kstep, voffA); PG8_STAGE(PG8_SB(1, 1), cB + hstep + kstep, voffB);
        PG8_WAIT_V(6); PG8_BAR;
    }
    for (;;) {
        const bool has_next = S.next(ui + 1, nxt);
        const char* nA = has_next ? (const char*)g.A + (size_t)nxt.pm * tstep : cA; const char* nB = has_next ? (const char*)g.Bt + (size_t)nxt.pn * tstep : cB;
        for (int t = 0; t < nt; t += 2) {
            const bool last = (t == nt - 2);
            if constexpr (RS) {
                PG8_LAS float* rst = (PG8_LAS float*)(lds + STAGE_BYTES);
                if (t == 2 && wid < 4) { const float* p = g.ssq + (size_t)(cur.pm * BM + tid) * 8; rsa = *(const f32x4*)p; rsb = *(const f32x4*)(p + 4); }
                if (t == 4 && wid < 4) rst[tid] = 1.0f / sqrtf((((rsa[0] + rsa[1]) + (rsa[2] + rsa[3])) + (rsb[0] + rsb[1])) * (1.0f / 384.0f) + 1e-6f);
                if (t == 6) {
#pragma unroll
                    for (int ai = 0; ai < 2; ++ai)
#pragma unroll
                        for (int m = 0; m < 4; ++m) { const float r = rst[ai * HALF + wr * 64 + m * 16 + fr];
#pragma unroll
                            for (int bj = 0; bj < 2; ++bj)
#pragma unroll
                                for (int n = 0; n < 2; ++n) acc[ai][bj][m][n] *= r; } }
            }
            const char* a1 = cA + (size_t)(t + 1) * kstep;
            const char* a2 = last ? nA : cA + (size_t)(t + 2) * kstep; const char* b2 = last ? nB : cB + (size_t)(t + 2) * kstep;
            const char* a3 = a2 + kstep; const char* b3 = b2 + kstep;
            if (last && has_next) S.a_ready(nxt);
            if constexpr (SP2) {
            PG8_LDB(B0, 0, 0); PG8_LDB(B1, 0, 1); PG8_SCHED; PG8_LDA(At, 0, 0); PG8_STAGE(PG8_SA(1, 1), a1 + hstep, voffA);
            PG8_WAIT_V(8); PG8_WAIT_L(0); PG8_BAR; PG8_MMA(0, 0, At, B0); PG8_MMA(0, 1, At, B1); PG8_BAR; PG8_SCHED;
            PG8_LDA(At, 0, 1); PG8_STAGE(PG8_SB(0, 0), b2, voffB); PG8_STAGE(PG8_SB(0, 1), b2 + hstep, voffB); PG8_STAGE(PG8_SA(0, 0), a2, voffA);
            PG8_WAIT_V(8); PG8_WAIT_L(0); PG8_BAR; PG8_MMA(1, 0, At, B0); PG8_MMA(1, 1, At, B1); PG8_BAR; PG8_SCHED;
            PG8_LDB(B0, 1, 0); PG8_LDB(B1, 1, 1); PG8_SCHED; PG8_LDA(At, 1, 0); PG8_STAGE(PG8_SA(0, 1), a2 + hstep, voffA);
            PG8_WAIT_V(8); PG8_WAIT_L(0); PG8_BAR; PG8_MMA(0, 0, At, B0); PG8_MMA(0, 1, At, B1); PG8_BAR; PG8_SCHED;
            PG8_LDA(At, 1, 1); PG8_STAGE(PG8_SB(1, 0), b3, voffB); PG8_STAGE(PG8_SB(1, 1), b3 + hstep, voffB); PG8_STAGE(PG8_SA(1, 0), a3, voffA);
            PG8_WAIT_V(8); PG8_WAIT_L(0); PG8_BAR; PG8_MMA(1, 0, At, B0); PG8_MMA(1, 1, At, B1); PG8_BAR; PG8_SCHED;
            } else {
            PG8_LDB(B0, 0, 0); PG8_SCHED; PG8_LDA(At, 0, 0); PG8_STAGE(PG8_SA(1, 1), a1 + hstep, voffA);
            PG8_WAIT_L(8); PG8_BAR; PG8_WAIT_L(0); PG8_MMA(0, 0, At, B0); PG8_BAR; PG8_SCHED;
            PG8_LDB(B1, 0, 1); PG8_STAGE(PG8_SB(0, 0), b2, voffB);
            PG8_BAR; PG8_WAIT_L(0); PG8_MMA(0, 1, At, B1); PG8_BAR;
            PG8_LDA(At, 0, 1); PG8_STAGE(PG8_SA(0, 0), a2, voffA);
            PG8_BAR; PG8_WAIT_L(0); PG8_MMA(1, 0, At, B0); PG8_BAR; PG8_SCHED;
            PG8_STAGE(PG8_SB(0, 1), b2 + hstep, voffB);
            PG8_WAIT_V(6); PG8_BAR; PG8_MMA(1, 1, At, B1); PG8_BAR;
            PG8_LDB(B0, 1, 0); PG8_SCHED; PG8_LDA(At, 1, 0); PG8_STAGE(PG8_SA(0, 1), a2 + hstep, voffA);
            PG8_WAIT_L(8); PG8_BAR; PG8_WAIT_L(0); PG8_MMA(0, 0, At, B0); PG8_BAR; PG8_SCHED;
            PG8_LDB(B1, 1, 1); PG8_STAGE(PG8_SB(1, 0), b3, voffB);
            PG8_BAR; PG8_WAIT_L(0); PG8_MMA(0, 1, At, B1); PG8_BAR;
            PG8_LDA(At, 1, 1); PG8_STAGE(PG8_SA(1, 0), a3, voffA);
            PG8_BAR; PG8_WAIT_L(0); PG8_MMA(1, 0, At, B0); PG8_BAR; PG8_SCHED;
            PG8_STAGE(PG8_SB(1, 1), b3 + hstep, voffB);
            PG8_WAIT_V(6); PG8_BAR; PG8_MMA(1, 1, At, B1); PG8_BAR;
            }
        }
        if constexpr (ALIGN_EPI) { if (wr == 0) PG8_BAR; }
        if constexpr (!Epi::AFTER_DRAIN) { E(acc, cur, wr, wc, fr, fq); S.done(cur); }
        if (!has_next) break;
#pragma unroll
        for (int a = 0; a < 2; ++a)
#pragma unroll
            for (int b = 0; b < 2; ++b)
#pragma unroll
                for (int m = 0; m < 4; ++m)
#pragma unroll
                    for (int n = 0; n < 2; ++n) acc[a][b][m][n] = (f32x4){0.f, 0.f, 0.f, 0.f};
        cur = nxt; cA = nA; cB = nB; ++ui;
        if constexpr (ALIGN_EPI) { if (wr == 1) PG8_BAR; }
    }
    PG8_WAIT_V(0);
    if constexpr (!ALIGN_EPI) { if (wr == 0) PG8_BAR; }
    PG8_BAR;
    if constexpr (Epi::AFTER_DRAIN) { E.fused(acc, cur, wr, wc, fr, fq, lds, wid, lane); S.done(cur); }
#undef PG8_SA
#undef PG8_SB
#undef PG8_STAGE
#undef PG8_LDA
#undef PG8_LDB
#undef PG8_MMA
#undef PG8_WAIT_V
#undef PG8_WAIT_L
#undef PG8_BAR
#undef PG8_SCHED
}
}
#include <hip/hip_bf16.h>
#include <cmath>
namespace attn_body {
using bf16=__hip_bfloat16;
using bf16x8=__attribute__((ext_vector_type(8)))short;
using s16x4=__attribute__((ext_vector_type(4)))short;
using f32x16=__attribute__((ext_vector_type(16)))float;
using u32x4=__attribute__((ext_vector_type(4)))unsigned;
using f32x4v=__attribute__((ext_vector_type(4)))float;
constexpr int BATCH=8,NHEAD=6,SEQ=8192,D=64,DM=NHEAD*D,ODM=1024;
constexpr int NW=8,QBLK=32,QB=QBLK*NW,KVBLK=64,NQB=SEQ/QB;
constexpr int ATTN_PITCH=DM, ATTN_UNIT_ROWS=QB;
__device__ __forceinline__ int crow(int r,int hi){return (r&3)+8*(r>>2)+4*hi;}
#define SBAR() __builtin_amdgcn_sched_barrier(0)
__device__ __forceinline__ void cmask(f32x16&p0,f32x16&p1,int jb,int qrel,int hi){
  const float NEG=-INFINITY; int kb=64*jb+4*hi;
  #pragma unroll
  for(int r=0;r<16;++r){int kv=kb+(r&3)+8*(r>>2); if(kv>qrel)p0[r]=NEG; if(kv+32>qrel)p1[r]=NEG;}
}

constexpr int NSLOT=3, SLOTB=8192;
constexpr int LDS_K=0, LDS_V=NSLOT*SLOTB, LDS_WS=2*NSLOT*SLOTB, LDS_OST=LDS_WS+NW*64*4, LDS_CT=LDS_OST+NW*4096, LDS_BYTES=LDS_CT+SEQ*4;
constexpr float C2=0.125f*1.4426950408889634f;
__device__ __forceinline__ void glds16(const void*gsrc,unsigned lds_dst){unsigned keep;
  asm volatile("s_mov_b32 %0, m0\n\ts_mov_b32 m0, %2\n\ts_nop 0\n\tglobal_load_lds_dwordx4 %1, off\n\ts_mov_b32 m0, %0":"=&s"(keep):"v"(gsrc),"s"(lds_dst):"memory");}
__device__ __forceinline__ float max3f(float a,float b,float c){float r;asm("v_max3_f32 %0, %1, %2, %3":"=v"(r):"v"(a),"v"(b),"v"(c));return r;}
__device__ __forceinline__ float max2f(float a,float b){float r;asm("v_max_f32_e32 %0, %1, %2":"=v"(r):"v"(a),"v"(b));return r;}
__device__ __forceinline__ float fadd_s(float a,float b){float r;asm("v_add_f32_e32 %0, %1, %2":"=v"(r):"v"(a),"v"(b));return r;}
__device__ __forceinline__ float fsub_s(float a,float b){float r;asm("v_sub_f32_e32 %0, %1, %2":"=v"(r):"v"(a),"v"(b));return r;}
typedef float f32x2_t __attribute__((ext_vector_type(2))); typedef __bf16 bf16x2_t __attribute__((ext_vector_type(2)));
__device__ __forceinline__ unsigned cvtpk_s(float lo,float hi){f32x2_t v={lo,hi};bf16x2_t b=__builtin_convertvector(v,bf16x2_t);return __builtin_bit_cast(unsigned,b);}
#define WAIT_BAR(N) asm volatile("s_waitcnt vmcnt(" #N ") lgkmcnt(0)\n\ts_barrier":::"memory")

__device__ __forceinline__ void qkt(f32x16&p0,f32x16&p1,const char*Kslot,const bf16x8*qr,int r32,int hi){
  const char*kb=Kslot+hi*1024+r32*16;
  #pragma unroll
  for(int d0=0;d0<4;++d0){
    const bf16x8 b0=*reinterpret_cast<const bf16x8*>(kb+d0*2048);
    const bf16x8 b1=*reinterpret_cast<const bf16x8*>(kb+d0*2048+512);
    {p0=__builtin_amdgcn_mfma_f32_32x32x16_bf16(b0,qr[d0],p0,0,0,0);p1=__builtin_amdgcn_mfma_f32_32x32x16_bf16(b1,qr[d0],p1,0,0,0);}}
}
typedef __attribute__((address_space(3))) const char* lds_cptr;
typedef short v4i16_t __attribute__((ext_vector_type(4)));
__device__ __forceinline__ void kload8(bf16x8*kf,lds_cptr kp){
  kf[0]=*(const __attribute__((address_space(3))) bf16x8*)(kp);      kf[1]=*(const __attribute__((address_space(3))) bf16x8*)(kp+512);
  kf[2]=*(const __attribute__((address_space(3))) bf16x8*)(kp+2048); kf[3]=*(const __attribute__((address_space(3))) bf16x8*)(kp+2560);
  kf[4]=*(const __attribute__((address_space(3))) bf16x8*)(kp+4096); kf[5]=*(const __attribute__((address_space(3))) bf16x8*)(kp+4608);
  kf[6]=*(const __attribute__((address_space(3))) bf16x8*)(kp+6144); kf[7]=*(const __attribute__((address_space(3))) bf16x8*)(kp+6656);
}
__device__ __forceinline__ void kload2(bf16x8*kf,lds_cptr kp,int j){ kf[2*j]=*(const __attribute__((address_space(3))) bf16x8*)(kp+j*2048); kf[2*j+1]=*(const __attribute__((address_space(3))) bf16x8*)(kp+j*2048+512); }
__device__ __forceinline__ s16x4 vtr(lds_cptr p){ return __builtin_bit_cast(s16x4,__builtin_amdgcn_ds_read_tr16_b64_v4i16((__attribute__((address_space(3))) v4i16_t*)p)); }
__device__ __forceinline__ float rowmax(const f32x16&p0,const f32x16&p1){
  float a=max3f(p0[0],p0[1],p1[0]),b=max3f(p0[2],p0[3],p1[1]);a=max3f(a,p1[2],p1[3]);
  #pragma unroll
  for(int r=4;r<16;r+=4){a=max3f(a,p0[r],p0[r+1]);b=max3f(b,p0[r+2],p0[r+3]);a=max3f(a,p1[r],p1[r+1]);b=max3f(b,p1[r+2],p1[r+3]);}
  const float m=max2f(a,b);
  auto rr=__builtin_amdgcn_permlane32_swap(__float_as_uint(m),__float_as_uint(m),false,false);
  return max2f(__uint_as_float(rr[0]),__uint_as_float(rr[1]));
}
__device__ __forceinline__ void pv(f32x16*o,int vb,bf16x8 pa0,bf16x8 pa1,bf16x8 pa2,bf16x8 pa3){
  #pragma unroll
  for(int d0=0;d0<2;++d0){s16x4 lo[4],hi[4];
    #pragma unroll
    for(int ks=0;ks<4;++ks){
      asm volatile("ds_read_b64_tr_b16 %0,%1 offset:%c2":"=&v"(lo[ks]):"v"(vb),"i"(d0*4096+ks*1024):"memory");
      asm volatile("ds_read_b64_tr_b16 %0,%1 offset:%c2":"=&v"(hi[ks]):"v"(vb),"i"(d0*4096+ks*1024+512):"memory");}
    asm volatile("s_waitcnt lgkmcnt(0)":::"memory");SBAR();
    #define PK(k) (bf16x8){lo[k][0],lo[k][1],lo[k][2],lo[k][3],hi[k][0],hi[k][1],hi[k][2],hi[k][3]}
    o[d0]=__builtin_amdgcn_mfma_f32_32x32x16_bf16(pa0,PK(0),o[d0],0,0,0);
    o[d0]=__builtin_amdgcn_mfma_f32_32x32x16_bf16(pa1,PK(1),o[d0],0,0,0);
    o[d0]=__builtin_amdgcn_mfma_f32_32x32x16_bf16(pa2,PK(2),o[d0],0,0,0);
    o[d0]=__builtin_amdgcn_mfma_f32_32x32x16_bf16(pa3,PK(3),o[d0],0,0,0);
    #undef PK
  }
}

#ifndef ATTN_STORE16
#define ATTN_STORE16(p,v) (*(u32x4*)(p)=(v))
#endif
template<int THRL> __device__ __forceinline__ void attn_unit(int b,int h,int qb,const bf16*Q,const bf16*__restrict__ K,const bf16*__restrict__ V,bf16*O,const float*__restrict__ CLrow,char*shm,float*SSQ){
  int tid=threadIdx.x; asm volatile("":"+v"(tid)); const int lane=tid&63,r32=lane&31,hi=lane>>5; const int wid=__builtin_amdgcn_readfirstlane(tid>>6);
  const long rowbase=(long)b*SEQ; const int q0=qb*QB;
  const bf16*Qw=Q+(rowbase+q0+wid*QBLK)*DM+h*D;
  const bf16*Kh=K+rowbase*DM+h*D,*Vh=V+rowbase*DM+h*D;
  const unsigned lds0=(unsigned)(uintptr_t)shm;
  float*wsf=(float*)(shm+LDS_WS)+wid*64;
  const bf16*ksrc=Kh+(long)lane*DM+wid*8;
  const bf16*vsrc=Vh+(long)(16*(wid&3)+(lane>>2))*DM+(wid>>2)*32+(lane&3)*8;
  const unsigned kdst=lds0+LDS_K+wid*1024, vdst=lds0+LDS_V+wid*1024;
  #define DMA_K(t,slot) glds16(ksrc+(long)(t)*KVBLK*DM,(unsigned)__builtin_amdgcn_readfirstlane(kdst+(slot)))
  #define DMA_V(t,slot) glds16(vsrc+(long)(t)*KVBLK*DM,(unsigned)__builtin_amdgcn_readfirstlane(vdst+(slot)))
  const int vb0=(int)(lds0+LDS_V)+((lane>>4)&1)*32+(lane&3)*8+(4*hi+((lane&15)>>2))*64;
  const char*Kbase=shm+LDS_K; bf16x8 kf[8];
  const lds_cptr shm3=(lds_cptr)shm; const lds_cptr kp0=shm3+LDS_K+hi*1024+r32*16; const lds_cptr vp0=shm3+LDS_V+((lane>>4)&1)*32+(lane&3)*8+(4*hi+((lane&15)>>2))*64;
  const int NT=(q0+QB)/KVBLK;
  { float*ct=(float*)(shm+LDS_CT); const int nk4=(q0+QB)>>2;
    for(int i=tid;i<nk4;i+=NW*64){ *(f32x4v*)(ct+4*i)=*(const f32x4v*)(CLrow+4*i); } }
  float cql=CLrow[q0+wid*QBLK+r32];
  asm volatile("s_waitcnt vmcnt(0) lgkmcnt(0)\n\ts_barrier":::"memory"); asm volatile("":"+v"(cql));
  typedef __attribute__((address_space(3))) const float* lds_fptr; const lds_fptr ct3=(lds_fptr)(shm3+LDS_CT);
  DMA_K(0,0);DMA_V(0,0);DMA_K(1,SLOTB);
  bf16x8 qr[4];
  #pragma unroll
  for(int d0=0;d0<4;++d0)qr[d0]=*reinterpret_cast<const bf16x8*>(&Qw[(long)r32*DM+d0*16+hi*8]);
  float mhat=0.f,l_reg=0.f;f32x16 o[2];o[0]=f32x16{};o[1]=f32x16{};float base=cql;
  const int qrel=wid*QBLK+r32;
  #define CMASK(P0,P1,t) do{int jb_=(t)-(NT-4); if(jb_>=0)cmask(P0,P1,jb_,qrel,hi);}while(0)
  bool resc=false;
  #define START(P0,P1) do{ const float rm=rowmax(P0,P1); resc=false; \
    { const float dl=rm; mhat=fadd_s(mhat,dl); \
      _Pragma("unroll") for(int r=0;r<16;++r){P0[r]=fsub_s(P0[r],dl);P1[r]=fsub_s(P1[r],dl);} \
      base=cql-mhat; } \
    _Pragma("unroll") for(int r=0;r<16;++r)P0[r]=__builtin_amdgcn_exp2f(P0[r]); }while(0)
  #define RESC() do{ if(resc){ asm volatile("s_waitcnt lgkmcnt(0)":::"memory"); \
      _Pragma("unroll") for(int d_=0;d_<2;++d_) _Pragma("unroll") for(int r=0;r<16;++r)o[d_][r]*=wsf[crow(r,hi)]; } }while(0)
  f32x16 pA0,pA1,pB0,pB1;
  #define CINIT(C0,C1,t) do{ const lds_fptr cp_=ct3+64*(t)+4*hi; \
    _Pragma("unroll") for(int g_=0;g_<4;++g_){ const f32x4v a_=*(const __attribute__((address_space(3))) f32x4v*)(cp_+8*g_); const f32x4v b_=*(const __attribute__((address_space(3))) f32x4v*)(cp_+32+8*g_); \
      C0[4*g_]=base-a_[0];C0[4*g_+1]=base-a_[1];C0[4*g_+2]=base-a_[2];C0[4*g_+3]=base-a_[3]; \
      C1[4*g_]=base-b_[0];C1[4*g_+1]=base-b_[1];C1[4*g_+2]=base-b_[2];C1[4*g_+3]=base-b_[3]; } }while(0)
  int sl_prev=0,sl_cur=0,sl_next=SLOTB;
  #define ROT() do{sl_prev=sl_cur;sl_cur=sl_next;sl_next=(sl_next==(NSLOT-1)*SLOTB)?0:sl_next+SLOTB;}while(0)
  DMA_K(2,2*SLOTB);
  WAIT_BAR(3);
  CINIT(pA0,pA1,0); qkt(pA0,pA1,Kbase,qr,r32,hi);asm volatile("s_nop 15\n\ts_nop 7":"+v"(pA0),"+v"(pA1));CMASK(pA0,pA1,0);
  START(pA0,pA1);
  CINIT(pB0,pB1,1);
  _Pragma("unroll") for(int r=0;r<16;++r)pA1[r]=__builtin_amdgcn_exp2f(pA1[r]);
  WAIT_BAR(0);
  DMA_K(3,0);DMA_V(1,SLOTB);
  ROT();
  kload8(kf,kp0+sl_cur);
  WAIT_BAR(2);
  s16x4 vlo[8],vhi[8]; u32x4 pw0,pw1,pw2,pw3;
  #define PKW(P,B) cvtpk_s(P[B],P[B+1])
  #define PAF(k) __builtin_bit_cast(bf16x8,pw##k)
  #define VFR(i) (bf16x8){vlo[i][0],vlo[i][1],vlo[i][2],vlo[i][3],vhi[i][0],vhi[i][1],vhi[i][2],vhi[i][3]}
  #define PIN(x) asm volatile("":"+v"(x))
  #define MX3(a,b,c) __builtin_fmaxf(__builtin_fmaxf((a),(b)),(c))
  #define GAPA(MF,A0,A1,A2,A3,W0,W1,PW) do{ MF; sacc+=A0; sacc+=A1; sacc+=A2; sacc+=A3; PIN(sacc); W0; W1; PIN(PW); SBAR(); }while(0)
  #define EX(v) __builtin_amdgcn_exp2f(v)
  #define CLOAD(P0,P1,t1) do{ const lds_fptr cp_=ct3+64*(t1)+4*hi; \
    _Pragma("unroll") for(int g_=0;g_<4;++g_){ const f32x4v a_=*(const __attribute__((address_space(3))) f32x4v*)(cp_+8*g_); const f32x4v b_=*(const __attribute__((address_space(3))) f32x4v*)(cp_+32+8*g_); \
      P0[4*g_]=a_[0];P0[4*g_+1]=a_[1];P0[4*g_+2]=a_[2];P0[4*g_+3]=a_[3]; P1[4*g_]=b_[0];P1[4*g_+1]=b_[1];P1[4*g_+2]=b_[2];P1[4*g_+3]=b_[3]; } }while(0)
  #define GAPB(MF,X,B,Y,YB) do{ MF; X[B]=EX(X[B]); X[B+1]=EX(X[B+1]); X[B+2]=EX(X[B+2]); X[B+3]=EX(X[B+3]); Y[YB]=base-Y[YB]; Y[YB+1]=base-Y[YB+1]; Y[YB+2]=base-Y[YB+2]; Y[YB+3]=base-Y[YB+3]; PIN(X); PIN(Y); SBAR(); }while(0)
  #define VRD(i) do{ vlo[i]=vtr(vp_+(((i)>>2)*4096+((i)&3)*1024)); vhi[i]=vtr(vp_+(((i)>>2)*4096+((i)&3)*1024+512)); }while(0)
  #define KRD(G,j) do{ if(G){ kload2(kf,kp0+sl_next,j); SBAR(); } }while(0)
  #define STEP(C0,C1,P0,P1,t,GK,GV,GL) do{ SBAR(); \
    const lds_cptr vp_=vp0+sl_prev; \
    VRD(0); SBAR(); float sacc=(P0[0]+P0[1]); \
    GAPA(C0=__builtin_amdgcn_mfma_f32_32x32x16_bf16(kf[0],qr[0],C0,0,0,0), P0[2],P0[3],P0[4],P0[5],     pw0[0]=PKW(P0,0), pw0[1]=PKW(P0,2), pw0); \
    VRD(4); SBAR(); GAPA(C1=__builtin_amdgcn_mfma_f32_32x32x16_bf16(kf[1],qr[0],C1,0,0,0), P0[6],P0[7],P0[8],P0[9],     pw0[2]=PKW(P0,4), pw0[3]=PKW(P0,6), pw0); \
    VRD(1); SBAR(); GAPA(C0=__builtin_amdgcn_mfma_f32_32x32x16_bf16(kf[2],qr[1],C0,0,0,0),   P0[10],P0[11],P0[12],P0[13], pw1[0]=PKW(P0,8), pw1[1]=PKW(P0,10), pw1); \
    VRD(5); SBAR(); GAPA(C1=__builtin_amdgcn_mfma_f32_32x32x16_bf16(kf[3],qr[1],C1,0,0,0),   P0[14],P0[15],P1[0],P1[1],   pw1[2]=PKW(P0,12),pw1[3]=PKW(P0,14), pw1); \
    VRD(2); SBAR(); GAPA(C0=__builtin_amdgcn_mfma_f32_32x32x16_bf16(kf[4],qr[2],C0,0,0,0),   P1[2],P1[3],P1[4],P1[5],     pw2[0]=PKW(P1,0), pw2[1]=PKW(P1,2), pw2); \
    VRD(6); SBAR(); GAPA(C1=__builtin_amdgcn_mfma_f32_32x32x16_bf16(kf[5],qr[2],C1,0,0,0),   P1[6],P1[7],P1[8],P1[9],     pw2[2]=PKW(P1,4), pw2[3]=PKW(P1,6), pw2); \
    VRD(3); SBAR(); GAPA(C0=__builtin_amdgcn_mfma_f32_32x32x16_bf16(kf[6],qr[3],C0,0,0,0),   P1[10],P1[11],P1[12],P1[13], pw3[0]=PKW(P1,8), pw3[1]=PKW(P1,10), pw3); \
    VRD(7); SBAR(); GAPA(C1=__builtin_amdgcn_mfma_f32_32x32x16_bf16(kf[7],qr[3],C1,0,0,0),   P1[14],P1[15],0.f,0.f,       pw3[2]=PKW(P1,12),pw3[3]=PKW(P1,14), pw3); \
    l_reg+=sacc; \
    CLOAD(P0,P1,(t)+1); \
    if(GK){DMA_K((t)+3,sl_cur);} if(GV){DMA_V((t)+1,sl_next);} \
    CMASK(C0,C1,t); \
    { float a=MX3(C0[0],C0[1],C1[0]),b=MX3(C0[2],C0[3],C1[1]); a=MX3(a,C1[2],C1[3]); \
      _Pragma("unroll") for(int r=4;r<16;r+=4){a=MX3(a,C0[r],C0[r+1]);b=MX3(b,C0[r+2],C0[r+3]);a=MX3(a,C1[r],C1[r+1]);b=MX3(b,C1[r+2],C1[r+3]);} \
      float rm=__builtin_fmaxf(a,b); { auto rr=__builtin_amdgcn_permlane32_swap(__float_as_uint(rm),__float_as_uint(rm),false,false); rm=__builtin_fmaxf(__uint_as_float(rr[0]),__uint_as_float(rr[1])); } \
      resc=false; \
      if(__builtin_expect(__any(rm>(float)THRL),0)){ const float dl=__builtin_fmaxf(rm,0.f); mhat+=dl; \
        _Pragma("unroll") for(int r=0;r<16;++r){C0[r]-=dl;C1[r]-=dl;} \
        base=cql-mhat; \
        const float f=__builtin_amdgcn_exp2f(-dl); l_reg*=f; if(hi==0)wsf[r32]=f; resc=true; } } \
    SBAR(); \
    GAPB(o[0]=__builtin_amdgcn_mfma_f32_32x32x16_bf16(PAF(0),VFR(0),o[0],0,0,0), C0,0, P0,0); \
    GAPB(o[1]=__builtin_amdgcn_mfma_f32_32x32x16_bf16(PAF(0),VFR(4),o[1],0,0,0), C0,4, P0,4); \
    KRD(GL,0); GAPB(o[0]=__builtin_amdgcn_mfma_f32_32x32x16_bf16(PAF(1),VFR(1),o[0],0,0,0), C0,8, P0,8); \
    KRD(GL,1); GAPB(o[1]=__builtin_amdgcn_mfma_f32_32x32x16_bf16(PAF(1),VFR(5),o[1],0,0,0), C0,12, P0,12); \
    KRD(GL,2); GAPB(o[0]=__builtin_amdgcn_mfma_f32_32x32x16_bf16(PAF(2),VFR(2),o[0],0,0,0), C1,0, P1,0); \
    KRD(GL,3); GAPB(o[1]=__builtin_amdgcn_mfma_f32_32x32x16_bf16(PAF(2),VFR(6),o[1],0,0,0), C1,4, P1,4); \
    GAPB(o[0]=__builtin_amdgcn_mfma_f32_32x32x16_bf16(PAF(3),VFR(3),o[0],0,0,0), C1,8, P1,8); \
    GAPB(o[1]=__builtin_amdgcn_mfma_f32_32x32x16_bf16(PAF(3),VFR(7),o[1],0,0,0), C1,12, P1,12); \
    }while(0)
  int t=1;
  #undef CMASK
  #define CMASK(P0,P1,t) do{}while(0)
  for(;t+5<NT;t+=2){
    STEP(pB0,pB1,pA0,pA1,t,true,true,true);     WAIT_BAR(2); RESC(); ROT();
    STEP(pA0,pA1,pB0,pB1,t+1,true,true,true);   WAIT_BAR(2); RESC(); ROT();
  }
  #undef CMASK
  #define CMASK(P0,P1,t) do{int jb_=(t)-(NT-4); if(jb_>=0)cmask(P0,P1,jb_,qrel,hi);}while(0)
  #define ENDW(tt) do{ if((tt)+3<NT){WAIT_BAR(2);} else if((tt)+2<NT){WAIT_BAR(1);} else {WAIT_BAR(0);} }while(0)
  for(;t+1<NT;t+=2){
    STEP(pB0,pB1,pA0,pA1,t,(t+3<NT),(t+1<NT),(t+1<NT));       ENDW(t);   RESC(); ROT();
    STEP(pA0,pA1,pB0,pB1,t+1,(t+4<NT),(t+2<NT),(t+2<NT));     ENDW(t+1); RESC(); ROT();
  }
  STEP(pB0,pB1,pA0,pA1,NT-1,false,false,false); RESC();
  { float sacc=pB0[0]+pB0[1]; _Pragma("unroll") for(int r=2;r<16;++r)sacc+=pB0[r]; _Pragma("unroll") for(int r=0;r<16;++r)sacc+=pB1[r]; l_reg+=sacc;
    pw0=(u32x4){PKW(pB0,0),PKW(pB0,2),PKW(pB0,4),PKW(pB0,6)};pw1=(u32x4){PKW(pB0,8),PKW(pB0,10),PKW(pB0,12),PKW(pB0,14)};pw2=(u32x4){PKW(pB1,0),PKW(pB1,2),PKW(pB1,4),PKW(pB1,6)};pw3=(u32x4){PKW(pB1,8),PKW(pB1,10),PKW(pB1,12),PKW(pB1,14)};
    SBAR(); pv(o,vb0+sl_cur,PAF(0),PAF(1),PAF(2),PAF(3)); }
  #undef PKW
  #undef PAF
  #undef VFR
  #undef PIN
  #undef MX3
  #undef GAPA
  #undef GAPB
  #undef CLOAD
  #undef EX
  #undef VRD
  #undef KRD
  #undef STEP
  #undef ENDW
  {auto rr=__builtin_amdgcn_permlane32_swap(__float_as_uint(l_reg),__float_as_uint(l_reg),false,false);l_reg=__uint_as_float(rr[0])+__uint_as_float(rr[1]);}
  if(hi==0)wsf[32+r32]=l_reg;asm volatile("s_waitcnt lgkmcnt(0)":::"memory");
  float rli[16];
  #pragma unroll
  for(int r=0;r<16;++r)rli[r]=__builtin_amdgcn_rcpf(wsf[32+crow(r,hi)]);
  bf16*Ow=O+(rowbase+q0+wid*QBLK)*ODM+h*D;
  { bf16*stg=(bf16*)(shm+LDS_OST)+wid*2048;
    #pragma unroll
    for(int r=0;r<16;++r){const int orow=crow(r,hi);
      #pragma unroll
      for(int d0=0;d0<2;++d0)stg[orow*64+d0*32+r32]=__float2bfloat16(o[d0][r]*rli[r]);}
    asm volatile("s_waitcnt lgkmcnt(0)":::"memory");
    #pragma unroll
    for(int i=0;i<4;++i){const int row=i*8+(lane>>3),ch=lane&7; const u32x4 v=*(const u32x4*)(stg+row*64+ch*8); ATTN_STORE16(Ow+(long)row*ODM+ch*8,v);
      float sq=0.f;
      #pragma unroll
      for(int e=0;e<4;++e){const float lo=__uint_as_float(v[e]<<16),hi2=__uint_as_float(v[e]&0xffff0000u);sq+=lo*lo+hi2*hi2;}
      sq+=__shfl_xor(sq,1);sq+=__shfl_xor(sq,2);sq+=__shfl_xor(sq,4);
      if(ch==0)SSQ[(rowbase+q0+wid*QBLK+row)*8+h]=sq;} }
  asm volatile("s_waitcnt lgkmcnt(0)\n\ts_barrier":::"memory");
  #undef DMA_K
  #undef DMA_V
  #undef CMASK
  #undef START
  #undef CINIT
  #undef RESC
  #undef ROT
}
constexpr int ATTN_LDS_BYTES=LDS_BYTES;
#undef SBAR
#undef WAIT_BAR
}
constexpr int D = 1024, NB = 8, SEQ = 8192, MP = NB * SEQ, DB = 32, DS = 16, MS = DB * DS, M = MP + MS; static_assert(M == pg8::SM_ROWS, "gate matrix rows");
constexpr int NHA = 6, NHB = 6, HD = 64, WA = 384, WB = 384, WC = 256, DFF = 2816, DIN = 3218, NIN = 3328, NF1 = 2 * DFF, PAST = 4096, NCH = SEQ / 64;
constexpr float LOG2E = 1.4426950408889634f, QSCALE = 0.125f * LOG2E;
constexpr int NWAVES = 8;
constexpr size_t O_YP = 0, O_YS = O_YP + (size_t)MP * D, O_KP = O_YS + (size_t)MS * D, O_VP = O_KP + 2ull * MP * WA, O_LFP = O_VP + 2ull * MP * WA, O_CVP = O_LFP + 2ull * MP * NHA,
                 O_SP = O_CVP + 2ull * NB * 3 * 1152, O_KS = O_SP + 2ull * NB * NHB * 4096, O_VS = O_KS + 2ull * MS * WA, O_LFS = O_VS + 2ull * MS * WA, O_CVS = O_LFS + 2ull * MS * NHA,
                 O_SS = O_CVS + 2ull * DB * 3 * 1152, O_CS = O_SS + 2ull * DB * NHB * 4096, O_END = O_CS + 2ull * MS * WC;
constexpr size_t MiB = 1u << 20;
constexpr size_t WS_CTL = 0, CTL_ZERO_BYTES = 1 * MiB;
constexpr size_t WS_WIN = 2 * MiB, WS_WOUT = 16 * MiB, WS_WF1 = 20 * MiB, WS_WF2 = 42 * MiB, WS_WSG = 53 * MiB, WS_SM = 54 * MiB, WS_CL = 63 * MiB, WS_GL = 65 * MiB;
constexpr size_t WS_H = 66 * MiB, WS_Q = 195 * MiB, WS_K = 244 * MiB, WS_V = 293 * MiB, WS_BQKV = 342 * MiB, WS_BZ = 488 * MiB, WS_CU = 537 * MiB, WS_CV = 570 * MiB;
constexpr size_t WS_ACT = WS_Q;
constexpr size_t WS_PREP = 603 * MiB;
constexpr size_t WS_M1 = WS_PREP;
constexpr size_t WS_CAT = 843 * MiB;
constexpr size_t WS_M2 = WS_CAT;
constexpr size_t WS_XR = 972 * MiB;
constexpr size_t WS_PART = 1101 * MiB;
constexpr size_t WS_SSQ = 1105 * MiB;
constexpr size_t WS_END = 1108 * MiB;
static_assert(WS_WIN + 2ull * NIN * D * 2 <= WS_WOUT && WS_WOUT + 2ull * D * D * 2 <= WS_WF1 && WS_WF1 + 2ull * NF1 * D * 2 <= WS_WF2 && WS_WF2 + 2ull * D * DFF * 2 <= WS_WSG && WS_WSG + 2ull * 4 * 128 * 128 * 2 <= WS_SM, "ws map 1");
static_assert(WS_SM + (size_t)M * 32 * 4 <= WS_CL && WS_CL + 48ull * SEQ * 4 <= WS_GL && WS_GL + 6144 * 4 <= WS_H && WS_H + (size_t)M * D * 2 <= WS_Q && WS_Q + (size_t)M * WA * 2 <= WS_K && WS_K + (size_t)M * WA * 2 <= WS_V, "ws map 2");
static_assert(WS_V + (size_t)M * WA * 2 <= WS_BQKV && WS_BQKV + (size_t)M * 1152 * 2 <= WS_BZ && WS_BZ + (size_t)M * WB * 2 <= WS_CU && WS_CU + (size_t)M * WC * 2 <= WS_CV && WS_CV + (size_t)M * WC * 2 <= WS_PREP, "ws map 3");
static_assert(WS_ACT + (size_t)M * DFF * 2 <= WS_PREP && WS_PREP + 6144ull * 40960 <= WS_CAT && WS_M1 + (size_t)M * D * 2 <= WS_CAT && WS_CAT + (size_t)M * D * 2 <= WS_XR && WS_XR + (size_t)M * D * 2 <= WS_END, "ws map 4");
constexpr int CW_BAR = 4096;
constexpr int CW_QUEUE = 81920;
constexpr int N_PHASES = 19;
constexpr int LDS_BYTES = 159744;
constexpr int MISC_OFF = 155648;
constexpr int PREP_WAVE_LDS = 19456;

#define DI __device__ __forceinline__
#define GAS __attribute__((address_space(1)))
#define LAS __attribute__((address_space(3)))
typedef unsigned short bf16;
typedef unsigned v4u __attribute__((ext_vector_type(4)));
typedef unsigned v2u __attribute__((ext_vector_type(2)));
typedef float f32x4 __attribute__((ext_vector_type(4)));
typedef short bf16x8 __attribute__((ext_vector_type(8)));
#define RLX_AGENT __ATOMIC_RELAXED, __HIP_MEMORY_SCOPE_AGENT
#define LDS_WAIT() asm volatile("s_waitcnt lgkmcnt(0)" ::: "memory")
#define VM_WAIT() asm volatile("s_waitcnt vmcnt(0)" ::: "memory")
#define MFMA16(a, b, c) __builtin_amdgcn_mfma_f32_16x16x32_bf16((a), (b), (c), 0, 0, 0)
typedef float f32x2c __attribute__((ext_vector_type(2))); typedef __bf16 bf16x2c __attribute__((ext_vector_type(2)));
DI unsigned pk2(float lo, float hi) { const f32x2c v = {lo, hi}; const bf16x2c b = __builtin_convertvector(v, bf16x2c); return __builtin_bit_cast(unsigned, b); }
DI bf16 f2bf(float x) { return (bf16)(pk2(x, 0.f) & 0xffffu); }
DI float bf2f(bf16 h) { return __builtin_bit_cast(float, (unsigned)h << 16); }
DI float bflo(unsigned w) { return __builtin_bit_cast(float, w << 16); }
DI float bfhi(unsigned w) { return __builtin_bit_cast(float, w & 0xffff0000u); }
DI float wave_sum(float v) {
#pragma unroll
    for (int o = 1; o < 64; o <<= 1) v += __shfl_xor(v, o);
    return v; }
DI float wave_max(float v) {
#pragma unroll
    for (int o = 1; o < 64; o <<= 1) v = fmaxf(v, __shfl_xor(v, o));
    return v; }
DI float wave_incl_scan(float v, int lane) {
#pragma unroll
    for (int o = 1; o < 64; o <<= 1) { const float t = __shfl_up(v, o); if (lane >= o) v += t; }
    return v; }
DI bf16x8 pack8(const f32x4 a, const f32x4 b) { v4u p; p.x = pk2(a[0], a[1]); p.y = pk2(a[2], a[3]); p.z = pk2(b[0], b[1]); p.w = pk2(b[2], b[3]); return __builtin_bit_cast(bf16x8, p); }
DI int pinv(int t) { return 32 * (t >> 5) + 8 * ((t >> 2) & 3) + 4 * ((t >> 4) & 1) + (t & 3); }
#define XB_TMO      128
#define XB_XCNT(j)  (256  + 64 * (j))
#define XB_XSUB(j)  (1280 + 64 * (j))
#define XB_XGEN(j)  (2304 + 64 * (j))
#define XB_TOP      3328
#define XB_TOPGEN   3392
#define XCD_BAR_WORDS 3456
#define XB_SPIN_CAP (1u << 18)

__device__ __forceinline__ unsigned xb_ld(unsigned* p)              { return __hip_atomic_load(p, __ATOMIC_RELAXED, __HIP_MEMORY_SCOPE_AGENT); }
__device__ __forceinline__ unsigned xb_add(unsigned* p, unsigned v) { return __hip_atomic_fetch_add(p, v, __ATOMIC_RELAXED, __HIP_MEMORY_SCOPE_AGENT); }
__device__ __forceinline__ unsigned xb_xcc_id() { return (unsigned)__builtin_amdgcn_s_getreg((3 << 11) | 20) & 0xFu; }
#define XB_SPIN(cond, bar) do { unsigned _sp = 0; while (cond) { __builtin_amdgcn_s_sleep(1); \
    if ((++_sp & 255u) == 0u) { if (xb_ld(&(bar)[XB_TMO])) break; if (_sp > XB_SPIN_CAP) { atomicAdd(&(bar)[XB_TMO], 1u); break; } } } } while (0)

struct XcdBarrier {
    unsigned* bar; unsigned x;
    volatile LAS unsigned* st;
};

__device__ __forceinline__ XcdBarrier xcd_barrier_post(unsigned* bar, volatile LAS unsigned* st) {
    XcdBarrier b; b.bar = bar; b.x = xb_xcc_id(); b.st = st;
    if (threadIdx.x == 0) (void)xb_add(&bar[XB_XCNT(b.x)], 1u);
    return b;
}
__device__ __forceinline__ void xcd_barrier_complete(unsigned* bar, unsigned x, unsigned& nloc, unsigned& nx) {
    const unsigned G = gridDim.x * gridDim.y * gridDim.z;
    unsigned sum, cnt, mine, sp = 0u;
    for (;;) {
        sum = 0u; cnt = 0u; mine = 0u;
#pragma unroll
        for (unsigned j = 0; j < 16; ++j) { const unsigned c = xb_ld(&bar[XB_XCNT(j)]); sum += c; cnt += (c > 0u) ? 1u : 0u; mine = (j == x) ? c : mine; }
        if (sum == G) break;
        __builtin_amdgcn_s_sleep(1);
        if ((++sp & 255u) == 0u) { if (xb_ld(&bar[XB_TMO])) break; if (sp > XB_SPIN_CAP) { atomicAdd(&bar[XB_TMO], 1u); break; } }
    }
    nloc = mine > 0u ? mine : 1u; nx = cnt > 0u ? cnt : 1u;
}

__device__ __forceinline__ void xcd_barrier(const XcdBarrier& b) {
    asm volatile("s_waitcnt vmcnt(0)" ::: "memory");
    __syncthreads();
    if (threadIdx.x == 0) {
        unsigned* bar = b.bar;
        __builtin_amdgcn_s_waitcnt(0);
        unsigned nloc = b.st[0], nx = b.st[1];
        if (nloc == 0u) { xcd_barrier_complete(bar, b.x, nloc, nx); b.st[0] = nloc; b.st[1] = nx; }
        const unsigned old = xb_add(&bar[XB_XSUB(b.x)], 1u);
        const unsigned gen = old / nloc;
        if (old + 1u == (gen + 1u) * nloc) {
            __builtin_amdgcn_fence(__ATOMIC_RELEASE, "agent");
            asm volatile("s_waitcnt vmcnt(0)" ::: "memory");
            const unsigned og = xb_add(&bar[XB_TOP], 1u);
            const unsigned tg = og / nx;
            if (og + 1u == (tg + 1u) * nx) xb_add(&bar[XB_TOPGEN], 1u);
            else XB_SPIN(xb_ld(&bar[XB_TOPGEN]) == tg, bar);
            __builtin_amdgcn_fence(__ATOMIC_ACQUIRE, "agent");
            xb_add(&bar[XB_XGEN(b.x)], 1u);
            asm volatile("s_waitcnt vmcnt(0)" ::: "memory");
        } else {
            XB_SPIN(xb_ld(&bar[XB_XGEN(b.x)]) == gen, bar);
            __builtin_amdgcn_fence(__ATOMIC_ACQUIRE, "agent");
            asm volatile("s_waitcnt vmcnt(0)" ::: "memory");
        }
    }
    __syncthreads();
}
DI int colmap_in(int n) {
    const int hh = n >> 7, c = n & 127;
    if (hh < 9) return hh * 128 + c;
    if (hh < 18) return 1158 + (hh - 9) * 128 + c;
    if (hh < 21) return 2322 + (hh - 18) * 128 + c;
    if (hh < 23) return 2706 + (hh - 21) * 128 + c;
    if (hh < 25) return 2962 + (hh - 23) * 128 + c;
    if (c < 6) return 1152 + c;
    if (c < 12) return 2310 + (c - 6);
    if (c < 18) return 2316 + (c - 12);
    return -1;
}
DI int colmap_f1(int n) { const int pn = n >> 8, bj = (n >> 7) & 1, c = n & 127; return bj * DFF + pn * 128 + c; }
template <int MAP> DI void p0_transpose_item(const float* W, int K, int N, int nblk, bf16* WT, LAS float* scr, int item, int lane, const float* kscale = nullptr, int kscale_n = 0) {
    const int kb = item / nblk, nb = item % nblk, k0 = 64 * kb, n0 = 32 * nb;
    const int nn = n0 + (lane & 31); const int sc = MAP == 1 ? colmap_in(nn) : MAP == 2 ? colmap_f1(nn) : nn;
#pragma unroll 8
    for (int i = 0; i < 32; ++i) { const int kk = 2 * i + (lane >> 5); float wv = sc >= 0 ? W[(size_t)(k0 + kk) * N + sc] : 0.f; if (kscale && k0 < kscale_n) wv *= kscale[k0 + kk]; scr[kk * 33 + (lane & 31)] = wv; }
    LDS_WAIT(); asm volatile("" ::: "memory");
    const int c = lane & 7;
#pragma unroll
    for (int j = 0; j < 4; ++j) { const int n = (lane >> 3) + 8 * j; const LAS float* s = scr + (8 * c) * 33 + n;
        v4u o; o.x = pk2(s[0 * 33], s[1 * 33]); o.y = pk2(s[2 * 33], s[3 * 33]); o.z = pk2(s[4 * 33], s[5 * 33]); o.w = pk2(s[6 * 33], s[7 * 33]);
        *(v4u*)(WT + (size_t)(n0 + n) * K + k0 + 8 * c) = o; }
    LDS_WAIT(); asm volatile("" ::: "memory");
}
template <int R, class XIN> DI void rms_rows_to_bf16(int m0, int stride, int mend, XIN xin_of, const float* g, bf16* Hb, int lane) {
    f32x4 v[R][4];
#pragma unroll
    for (int r = 0; r < R; ++r) { const int m = min(m0 + r * stride, mend - 1); const f32x4* xr = (const f32x4*)xin_of(m) + lane;
#pragma unroll
        for (int j = 0; j < 4; ++j) v[r][j] = xr[64 * j]; }
    f32x4 gg[4];
#pragma unroll
    for (int j = 0; j < 4; ++j) gg[j] = ((const f32x4*)g + lane)[64 * j];
#pragma unroll
    for (int r = 0; r < R; ++r) { const int m = m0 + r * stride; if (m < mend) { float s = 0.f;
#pragma unroll
        for (int j = 0; j < 4; ++j) s += (v[r][j].x * v[r][j].x + v[r][j].y * v[r][j].y) + (v[r][j].z * v[r][j].z + v[r][j].w * v[r][j].w);
        const float rs = 1.0f / sqrtf(wave_sum(s) * (1.f / D) + 1e-6f);
        v2u* o8 = (v2u*)(Hb + (size_t)m * D) + lane;
#pragma unroll
        for (int j = 0; j < 4; ++j) { v2u w; w.x = pk2(v[r][j].x * rs * gg[j].x, v[r][j].y * rs * gg[j].y); w.y = pk2(v[r][j].z * rs * gg[j].z, v[r][j].w * rs * gg[j].w); o8[64 * j] = w; } } }
}
struct RowsF32Split { const float* p; const float* s; __device__ __forceinline__ const float* operator()(int m) const { return m < MP ? p + (size_t)m * D : s + (size_t)(m - MP) * D; } };
struct PairF32 { const float* p0; const float* p1; };
template <class T> struct IsPair { static constexpr bool v = false; }; template <> struct IsPair<PairF32> { static constexpr bool v = true; };
struct RowsBf16 { bf16* b; __device__ __forceinline__ bf16* operator()(int m) const { return b + (size_t)m * D; } };
template <bool XF32, bool OF32, int R, class MSRC, class XIN, class XOUT> DI void norm_res_rows(int m0, int stride, int mend, MSRC Mb, XIN xin_of, XOUT xout_of, const float* g1, const float* gn, bf16* Hb, int lane) {
    constexpr bool PAIR = IsPair<MSRC>::v;
    v4u mw[R][2]; f32x4 xf[R][2][2]; v4u xb[R][2]; f32x4 pa[R][2][2], pb[R][2][2];
#pragma unroll
    for (int r = 0; r < R; ++r) { const int m = min(m0 + r * stride, mend - 1);
#pragma unroll
        for (int j = 0; j < 2; ++j) {
            if constexpr (PAIR) { const float* a = Mb.p0 + (size_t)(m - MP) * D + 512 * j; const float* b = Mb.p1 + (size_t)(m - MP) * D + 512 * j;
                pa[r][j][0] = *((const f32x4*)a + 2 * lane); pa[r][j][1] = *((const f32x4*)a + 2 * lane + 1); pb[r][j][0] = *((const f32x4*)b + 2 * lane); pb[r][j][1] = *((const f32x4*)b + 2 * lane + 1); }
            else mw[r][j] = *((const v4u*)(Mb + (size_t)m * D + 512 * j) + lane);
            if (XF32) { const float* xin = (const float*)xin_of(m); xf[r][j][0] = *((const f32x4*)(xin + 512 * j) + 2 * lane); xf[r][j][1] = *((const f32x4*)(xin + 512 * j) + 2 * lane + 1); }
            else xb[r][j] = *((const v4u*)((const bf16*)xin_of(m) + 512 * j) + lane); } }
    float gg1[16], ggn[16];
#pragma unroll
    for (int j = 0; j < 2; ++j) { const f32x4 ga = *((const f32x4*)(g1 + 512 * j) + 2 * lane), gb = *((const f32x4*)(g1 + 512 * j) + 2 * lane + 1);
        gg1[8 * j] = ga.x; gg1[8 * j + 1] = ga.y; gg1[8 * j + 2] = ga.z; gg1[8 * j + 3] = ga.w; gg1[8 * j + 4] = gb.x; gg1[8 * j + 5] = gb.y; gg1[8 * j + 6] = gb.z; gg1[8 * j + 7] = gb.w;
        if (gn) { const f32x4 na = *((const f32x4*)(gn + 512 * j) + 2 * lane), nb = *((const f32x4*)(gn + 512 * j) + 2 * lane + 1);
            ggn[8 * j] = na.x; ggn[8 * j + 1] = na.y; ggn[8 * j + 2] = na.z; ggn[8 * j + 3] = na.w; ggn[8 * j + 4] = nb.x; ggn[8 * j + 5] = nb.y; ggn[8 * j + 6] = nb.z; ggn[8 * j + 7] = nb.w; } }
#pragma unroll
    for (int r = 0; r < R; ++r) { const int m = m0 + r * stride; const bool live = m < mend; {
        float mv[16], xv[16]; float s = 0.f;
#pragma unroll
        for (int j = 0; j < 2; ++j) {
            if constexpr (PAIR) { const f32x4 a = pa[r][j][0] + pb[r][j][0], b = pa[r][j][1] + pb[r][j][1];
                mv[8 * j + 0] = a.x; mv[8 * j + 1] = a.y; mv[8 * j + 2] = a.z; mv[8 * j + 3] = a.w; mv[8 * j + 4] = b.x; mv[8 * j + 5] = b.y; mv[8 * j + 6] = b.z; mv[8 * j + 7] = b.w; }
            else { const v4u w = mw[r][j];
            mv[8 * j + 0] = bflo(w.x); mv[8 * j + 1] = bfhi(w.x); mv[8 * j + 2] = bflo(w.y); mv[8 * j + 3] = bfhi(w.y); mv[8 * j + 4] = bflo(w.z); mv[8 * j + 5] = bfhi(w.z); mv[8 * j + 6] = bflo(w.w); mv[8 * j + 7] = bfhi(w.w); }
            if (XF32) { const f32x4 a = xf[r][j][0], b = xf[r][j][1]; xv[8 * j + 0] = a.x; xv[8 * j + 1] = a.y; xv[8 * j + 2] = a.z; xv[8 * j + 3] = a.w; xv[8 * j + 4] = b.x; xv[8 * j + 5] = b.y; xv[8 * j + 6] = b.z; xv[8 * j + 7] = b.w; }
            else { const v4u x = xb[r][j]; xv[8 * j + 0] = bflo(x.x); xv[8 * j + 1] = bfhi(x.x); xv[8 * j + 2] = bflo(x.y); xv[8 * j + 3] = bfhi(x.y); xv[8 * j + 4] = bflo(x.z); xv[8 * j + 5] = bfhi(x.z); xv[8 * j + 6] = bflo(x.w); xv[8 * j + 7] = bfhi(x.w); } }
#pragma unroll
        for (int i = 0; i < 16; ++i) s += mv[i] * mv[i];
        const float rs = 1.0f / sqrtf(wave_sum(s) * (1.f / D) + 1e-6f);
        float s2 = 0.f;
#pragma unroll
        for (int j = 0; j < 2; ++j) {
#pragma unroll
            for (int e = 0; e < 8; ++e) { xv[8 * j + e] += mv[8 * j + e] * rs * gg1[8 * j + e]; s2 += xv[8 * j + e] * xv[8 * j + e]; }
            if (!live) continue;
            if (OF32) { float* xout = (float*)xout_of(m);
                *((f32x4*)(xout + 512 * j) + 2 * lane) = (f32x4){xv[8 * j], xv[8 * j + 1], xv[8 * j + 2], xv[8 * j + 3]};
                *((f32x4*)(xout + 512 * j) + 2 * lane + 1) = (f32x4){xv[8 * j + 4], xv[8 * j + 5], xv[8 * j + 6], xv[8 * j + 7]}; }
            else { v4u w; w.x = pk2(xv[8 * j], xv[8 * j + 1]); w.y = pk2(xv[8 * j + 2], xv[8 * j + 3]); w.z = pk2(xv[8 * j + 4], xv[8 * j + 5]); w.w = pk2(xv[8 * j + 6], xv[8 * j + 7]);
                *((v4u*)((bf16*)xout_of(m) + 512 * j) + lane) = w; } }
        if (gn && live) {
            const float rs2 = 1.0f / sqrtf(wave_sum(s2) * (1.f / D) + 1e-6f);
#pragma unroll
            for (int j = 0; j < 2; ++j) { v4u w; w.x = pk2(xv[8 * j] * rs2 * ggn[8 * j], xv[8 * j + 1] * rs2 * ggn[8 * j + 1]); w.y = pk2(xv[8 * j + 2] * rs2 * ggn[8 * j + 2], xv[8 * j + 3] * rs2 * ggn[8 * j + 3]);
                w.z = pk2(xv[8 * j + 4] * rs2 * ggn[8 * j + 4], xv[8 * j + 5] * rs2 * ggn[8 * j + 5]); w.w = pk2(xv[8 * j + 6] * rs2 * ggn[8 * j + 6], xv[8 * j + 7] * rs2 * ggn[8 * j + 7]);
                *((v4u*)(Hb + (size_t)m * D + 512 * j) + lane) = w; } }
    } }
}
DI float logsig_f(float y) { return fminf(y, 0.f) - log1pf(__expf(-fabsf(y))); }
DI float gdn_decay_f(float x, float a_log, float dt_bias) { return -__expf(a_log) * pg8::softplus_f(x + dt_bias); }
DI float sigmoid_f(float x) { return __builtin_amdgcn_rcpf(1.f + __expf(-x)); }
DI void cumsum_unit(int bh, const float* SM, const float* b_f, float* out_lf, float* CL, LAS unsigned char* lds, int tid, int lane, int wid) {
    asm volatile("" : "+v"(tid), "+v"(lane));
    const int b = bh / NHA, h = bh % NHA; LAS float* wt = (LAS float*)lds; LAS float* lfs = (LAS float*)(lds + 1024);
    float v[16]; float run = 0.f; const float bfh = b_f[h];
#pragma unroll
    for (int i = 0; i < 16; ++i) { const size_t row = (size_t)b * SEQ + tid * 16 + i; const float lf = logsig_f(SM[(size_t)h * M + row] + bfh); lfs[tid * 17 + i] = lf; run += lf; v[i] = run; }
    const float incl = wave_incl_scan(run, lane);
    if (lane == 63) wt[wid] = incl;
    LDS_WAIT(); __syncthreads();
#pragma unroll
    for (int i = 0; i < 16; ++i) { const int r = i * 512 + tid; out_lf[((size_t)b * SEQ + r) * NHA + h] = lfs[(r >> 4) * 17 + (r & 15)]; }
    float off = incl - run;
    for (int w = 0; w < wid; ++w) off += wt[w];
    float* dst = CL + (size_t)bh * SEQ + tid * 16;
#pragma unroll
    for (int i = 0; i < 4; ++i) *((f32x4*)dst + i) = (f32x4){(v[4 * i] + off) * LOG2E, (v[4 * i + 1] + off) * LOG2E, (v[4 * i + 2] + off) * LOG2E, (v[4 * i + 3] + off) * LOG2E};
    __syncthreads();
}
DI void sgate_unit(int u, const bf16* CU, const bf16* CV, const bf16* WSG, const float* g_cv, const float* b_cv, const float* b_s, const float* g_c_out, bf16* CAT, LAS unsigned char* lds, int tid, int lane, int wid) {
    asm volatile("" : "+v"(tid), "+v"(lane));
    const int row0 = u * 128; const int fr = lane & 15, fq = lane >> 4;
    LAS bf16* vnT = (LAS bf16*)lds;
    LAS float* part = (LAS float*)(lds + 256 * 272);
    LAS bf16* cus = (LAS bf16*)(lds + 73728);
#pragma unroll
    for (int p = 0; p < 8; ++p) { const int rr = 16 * wid + 2 * p;
        __builtin_amdgcn_global_load_lds((const unsigned*)(CU + (size_t)(row0 + rr) * WC + lane * 8), (LAS unsigned*)(lds + 73728 + rr * 512), 16, 0, 0); }
    { const int j = tid >> 2, qd = tid & 3; const bf16* src = CV + (size_t)(row0 + j) * WC + 8 * qd;
      float x[64]; float s1 = 0.f;
#pragma unroll
      for (int i = 0; i < 8; ++i) { const v4u w = *(const v4u*)(src + 32 * i); x[8 * i] = bflo(w.x); x[8 * i + 1] = bfhi(w.x); x[8 * i + 2] = bflo(w.y); x[8 * i + 3] = bfhi(w.y); x[8 * i + 4] = bflo(w.z); x[8 * i + 5] = bfhi(w.z); x[8 * i + 6] = bflo(w.w); x[8 * i + 7] = bfhi(w.w); }
#pragma unroll
      for (int i = 0; i < 64; ++i) s1 += x[i];
      s1 += __shfl_xor(s1, 1); s1 += __shfl_xor(s1, 2);
      const float mean = s1 * (1.f / 256.f); float s2 = 0.f;
#pragma unroll
      for (int i = 0; i < 64; ++i) { x[i] -= mean; s2 += x[i] * x[i]; }
      s2 += __shfl_xor(s2, 1); s2 += __shfl_xor(s2, 2);
      const float rstd = 1.0f / sqrtf(s2 * (1.f / 256.f) + 1e-5f);
#pragma unroll
      for (int i = 0; i < 64; ++i) { const int c = 32 * (i >> 3) + 8 * qd + (i & 7); vnT[c * 136 + j] = f2bf(x[i] * rstd * g_cv[c] + b_cv[c]); } }
    VM_WAIT(); LDS_WAIT(); __syncthreads();
    const int g = wid >> 1, ih = wid & 1;
    f32x4 acc[4][4];
#pragma unroll
    for (int mt = 0; mt < 4; ++mt)
#pragma unroll
        for (int nt = 0; nt < 4; ++nt) acc[mt][nt] = (f32x4){0.f, 0.f, 0.f, 0.f};
#pragma unroll
    for (int ks = 0; ks < 4; ++ks) { bf16x8 a[4], bb[4];
#pragma unroll
        for (int mt = 0; mt < 4; ++mt) a[mt] = *(const bf16x8*)(WSG + (size_t)(g * 128 + 64 * ih + 16 * mt + fr) * 128 + 32 * ks + 8 * fq);
#pragma unroll
        for (int nt = 0; nt < 4; ++nt) bb[nt] = *(const LAS bf16x8*)(vnT + (64 * g + 16 * nt + fr) * 136 + 32 * ks + 8 * fq);
#pragma unroll
        for (int mt = 0; mt < 4; ++mt)
#pragma unroll
            for (int nt = 0; nt < 4; ++nt) acc[mt][nt] = MFMA16(a[mt], bb[nt], acc[mt][nt]); }
#pragma unroll
    for (int mt = 0; mt < 4; ++mt)
#pragma unroll
        for (int r = 0; r < 4; ++r) { const int i = 64 * ih + 16 * mt + 4 * fq + r; const float bs = b_s[g * 128 + i]; float ss = 0.f;
#pragma unroll
            for (int nt = 0; nt < 4; ++nt) { const int c = 64 * g + 16 * nt + fr; const float oc = bf2f(cus[i * 256 + c]) * (acc[mt][nt][r] + bs); acc[mt][nt][r] = oc; ss += oc * oc; }
            ss += __shfl_xor(ss, 1); ss += __shfl_xor(ss, 2); ss += __shfl_xor(ss, 4); ss += __shfl_xor(ss, 8);
            if (fr == 0) part[g * 128 + i] = ss; }
    LDS_WAIT(); __syncthreads();
#pragma unroll
    for (int mt = 0; mt < 4; ++mt)
#pragma unroll
        for (int r = 0; r < 4; ++r) { const int i = 64 * ih + 16 * mt + 4 * fq + r; const float rs = 1.0f / sqrtf((part[i] + part[128 + i] + part[256 + i] + part[384 + i]) * (1.f / 256.f) + 1e-6f);
#pragma unroll
            for (int nt = 0; nt < 4; ++nt) { const int c = 64 * g + 16 * nt + fr; cus[i * 256 + c] = f2bf(acc[mt][nt][r] * rs * g_c_out[c]); } }
    LDS_WAIT(); __syncthreads();
#pragma unroll
    for (int p = 0; p < 8; ++p) { const int rr = 16 * wid + 2 * p + (lane >> 5); *(v4u*)(CAT + (size_t)(row0 + rr) * D + 768 + (lane & 31) * 8) = *(const LAS v4u*)(cus + rr * 256 + (lane & 31) * 8); }
    LDS_WAIT(); __syncthreads();
}
DI void sgate_sample_unit(int b, const bf16* CU, const bf16* CV, const float* w_s, const float* g_cv, const float* b_cv, const float* b_s, const float* g_c_out, bf16* CAT, float* out_cv, LAS unsigned char* lds, int tid) {
    asm volatile("" : "+v"(tid));
    LAS float* vn = (LAS float*)lds;
    const int i = tid >> 5, p8 = (tid & 31) * 8; const int row = MP + b * DS + i;
    { const v4u w = *(const v4u*)(CV + (size_t)row * WC + p8);
      float x[8] = {bflo(w.x), bfhi(w.x), bflo(w.y), bfhi(w.y), bflo(w.z), bfhi(w.z), bflo(w.w), bfhi(w.w)}; float s1 = 0.f;
#pragma unroll
      for (int e = 0; e < 8; ++e) s1 += x[e];
#pragma unroll
      for (int o = 1; o < 32; o <<= 1) s1 += __shfl_xor(s1, o);
      const float mean = s1 * (1.f / 256.f); float s2 = 0.f;
#pragma unroll
      for (int e = 0; e < 8; ++e) { x[e] -= mean; s2 += x[e] * x[e]; }
#pragma unroll
      for (int o = 1; o < 32; o <<= 1) s2 += __shfl_xor(s2, o);
      const float rstd = 1.0f / sqrtf(s2 * (1.f / 256.f) + 1e-5f);
#pragma unroll
      for (int e = 0; e < 8; ++e) { const float y = x[e] * rstd * g_cv[p8 + e] + b_cv[p8 + e]; vn[i * 256 + p8 + e] = y; out_cv[(size_t)(b * DS + i) * WC + p8 + e] = y; } }
    LDS_WAIT(); __syncthreads();
    { const int g = p8 >> 6; float s[8];
#pragma unroll
      for (int e = 0; e < 8; ++e) s[e] = b_s[g * 128 + i];
      for (int j = 0; j < DS; ++j) { const float w = w_s[(size_t)(g * 128 + i) * 128 + j];
#pragma unroll
          for (int e = 0; e < 8; ++e) s[e] += w * vn[j * 256 + p8 + e]; }
      const v4u uw = *(const v4u*)(CU + (size_t)row * WC + p8);
      const float uu[8] = {bflo(uw.x), bfhi(uw.x), bflo(uw.y), bfhi(uw.y), bflo(uw.z), bfhi(uw.z), bflo(uw.w), bfhi(uw.w)}; float ss = 0.f;
#pragma unroll
      for (int e = 0; e < 8; ++e) { s[e] *= uu[e]; ss += s[e] * s[e]; }
#pragma unroll
      for (int o = 1; o < 32; o <<= 1) ss += __shfl_xor(ss, o);
      const float rs = 1.0f / sqrtf(ss * (1.f / 256.f) + 1e-6f);
      v4u o; o.x = pk2(s[0] * rs * g_c_out[p8], s[1] * rs * g_c_out[p8 + 1]); o.y = pk2(s[2] * rs * g_c_out[p8 + 2], s[3] * rs * g_c_out[p8 + 3]);
      o.z = pk2(s[4] * rs * g_c_out[p8 + 4], s[5] * rs * g_c_out[p8 + 5]); o.w = pk2(s[6] * rs * g_c_out[p8 + 6], s[7] * rs * g_c_out[p8 + 7]);
      *(v4u*)(CAT + (size_t)row * D + 768 + p8) = o; }
    LDS_WAIT(); __syncthreads();
}
DI bf16x8 cvt8(const f32x4 a, const f32x4 b) { return pack8(a, b); }
DI void sattn_unit(int b, int h, const bf16* Qb, const bf16* Kb, const bf16* Vb, const float* SM, const float* b_f, float* out_lf, const float* ck, const float* cv, const float* clf, bf16* CAT, float* SSQ, LAS unsigned char* lds, int tid, int lane, int wid) {
    asm volatile("" : "+v"(tid), "+v"(lane));
    LAS float* wtot = (LAS float*)(lds + 4096);
    LAS float* Es = (LAS float*)(lds + 4096 + 64);
    LAS float* alS = (LAS float*)(lds + 8192) + wid * 16;
    LAS float* comb = (LAS float*)(lds + 40960);
    LAS float* DkS = (LAS float*)(lds + 76800) + wid * 512;
    const int rowq0 = MP + b * DS, fr = lane & 15, fq = lane >> 4;
    if (tid < DS) { float e = 0.f; const float bfh = b_f[h]; for (int t = 0; t <= tid; ++t) { const float lf = logsig_f(SM[(size_t)h * M + rowq0 + t] + bfh); e += lf; if (t == tid) out_lf[(size_t)(b * DS + t) * NHA + h] = lf; } Es[tid] = e; }
    { float Dk[8]; float tot = 0.f; const float* clfb = clf + (size_t)b * PAST * NHA + h;
#pragma unroll
      for (int tt = 0; tt < 8; ++tt) { Dk[tt] = clfb[(size_t)(512 * wid + 64 * tt + lane) * NHA]; tot += Dk[tt]; }
      tot = wave_sum(tot);
      if (lane == 0) wtot[wid] = tot;
      LDS_WAIT(); __syncthreads();
      float after = 0.f;
      for (int w = wid + 1; w < 8; ++w) after += wtot[w];
#pragma unroll
      for (int tt = 7; tt >= 0; --tt) { const float inc = wave_incl_scan(Dk[tt], lane); const float ttot = __shfl(inc, 63); DkS[64 * tt + lane] = (after + (ttot - inc)) * LOG2E; after += ttot; } }
    LDS_WAIT(); asm volatile("" ::: "memory");
    const float Eq = Es[fr] * LOG2E;
    bf16x8 Qf[2];
#pragma unroll
    for (int ks = 0; ks < 2; ++ks) Qf[ks] = *(const bf16x8*)(Qb + (size_t)(rowq0 + fr) * WA + h * HD + 32 * ks + 8 * fq);
    float m = -INFINITY, l = 0.f; f32x4 O[4];
#pragma unroll
    for (int T = 0; T < 4; ++T) O[T] = (f32x4){0.f, 0.f, 0.f, 0.f};
    const f32x4 z4 = (f32x4){0.f, 0.f, 0.f, 0.f};
    if (wid == 0) {
        const bf16* kp = Kb + (size_t)(rowq0 + fr) * WA + h * HD + 8 * fq;
        f32x4 S = MFMA16(*(const bf16x8*)kp, Qf[0], z4); S = MFMA16(*(const bf16x8*)(kp + 32), Qf[1], S);
        const f32x4 Ek = *(const LAS f32x4*)(Es + 4 * fq); float p[4]; float mx = -INFINITY;
#pragma unroll
        for (int r = 0; r < 4; ++r) { p[r] = (4 * fq + r <= fr) ? S[r] + Eq - Ek[r] * LOG2E : -INFINITY; mx = fmaxf(mx, p[r]); }
        mx = fmaxf(mx, __shfl_xor(mx, 16)); mx = fmaxf(mx, __shfl_xor(mx, 32));
        m = mx; float ps = 0.f;
#pragma unroll
        for (int r = 0; r < 4; ++r) { p[r] = __builtin_amdgcn_exp2f(p[r] - m); ps += p[r]; }
        l = ps;
        const bf16x8 Pa = pack8((f32x4){p[0], p[1], p[2], p[3]}, z4);
        v2u vw[4];
#pragma unroll
        for (int r = 0; r < 4; ++r) vw[r] = *(const v2u*)(Vb + (size_t)(rowq0 + 4 * fq + r) * WA + h * HD + 4 * fr);
#pragma unroll
        for (int T = 0; T < 4; ++T) { v4u bw;
            const unsigned e0 = (T & 2) ? vw[0].y : vw[0].x, e1 = (T & 2) ? vw[1].y : vw[1].x, e2 = (T & 2) ? vw[2].y : vw[2].x, e3 = (T & 2) ? vw[3].y : vw[3].x;
            const unsigned h0 = (T & 1) ? (e0 >> 16) : (e0 & 0xffffu), h1 = (T & 1) ? (e1 >> 16) : (e1 & 0xffffu), h2 = (T & 1) ? (e2 >> 16) : (e2 & 0xffffu), h3 = (T & 1) ? (e3 >> 16) : (e3 & 0xffffu);
            bw.x = h0 | (h1 << 16); bw.y = h2 | (h3 << 16); bw.z = 0u; bw.w = 0u;
            O[T] = MFMA16(Pa, __builtin_bit_cast(bf16x8, bw), O[T]); }
    }
    const float* kbase = ck + (((size_t)b * PAST + 512 * wid + fr) * NHA + h) * HD + 8 * fq;
    const float* vbase = cv + (((size_t)b * PAST + 512 * wid + 4 * fq) * NHA + h) * HD + 4 * fr;
    f32x4 Kr[4][2][2];
#pragma unroll
    for (int j = 0; j < 4; ++j)
#pragma unroll
        for (int ks = 0; ks < 2; ++ks) { const float* p = kbase + (size_t)(16 * j) * NHA * HD + 32 * ks; Kr[j][ks][0] = *(const f32x4*)p; Kr[j][ks][1] = *(const f32x4*)(p + 4); }
#pragma unroll 1
    for (int tt = 0; tt < 8; ++tt) {
        f32x4 Vr[2][8];
#pragma unroll
        for (int kk = 0; kk < 2; ++kk)
#pragma unroll
            for (int s8 = 0; s8 < 8; ++s8) Vr[kk][s8] = *(const f32x4*)(vbase + (size_t)(64 * tt + 16 * (2 * kk + (s8 >> 2)) + (s8 & 3)) * NHA * HD);
        f32x4 S[4];
#pragma unroll
        for (int j = 0; j < 4; ++j) { S[j] = MFMA16(cvt8(Kr[j][0][0], Kr[j][0][1]), Qf[0], z4); S[j] = MFMA16(cvt8(Kr[j][1][0], Kr[j][1][1]), Qf[1], S[j]); }
        if (tt < 7) {
#pragma unroll
            for (int j = 0; j < 4; ++j)
#pragma unroll
                for (int ks = 0; ks < 2; ++ks) { const float* p = kbase + (size_t)(64 * (tt + 1) + 16 * j) * NHA * HD + 32 * ks; Kr[j][ks][0] = *(const f32x4*)p; Kr[j][ks][1] = *(const f32x4*)(p + 4); }
        }
        float mx = -INFINITY;
#pragma unroll
        for (int j = 0; j < 4; ++j) { const f32x4 Dv = *(const LAS f32x4*)(DkS + 64 * tt + 16 * j + 4 * fq);
#pragma unroll
            for (int r = 0; r < 4; ++r) { S[j][r] += Eq + Dv[r]; mx = fmaxf(mx, S[j][r]); } }
        mx = fmaxf(mx, __shfl_xor(mx, 16)); mx = fmaxf(mx, __shfl_xor(mx, 32));
        const float mn = fmaxf(m, mx), al = __builtin_amdgcn_exp2f(m - mn); m = mn;
        if (fq == 0) alS[fr] = al;
        float ps = 0.f;
#pragma unroll
        for (int j = 0; j < 4; ++j)
#pragma unroll
            for (int r = 0; r < 4; ++r) { S[j][r] = __builtin_amdgcn_exp2f(S[j][r] - mn); ps += S[j][r]; }
        l = l * al + ps;
        const bf16x8 P0 = pack8(S[0], S[1]), P1 = pack8(S[2], S[3]);
        LDS_WAIT(); asm volatile("" ::: "memory");
        const f32x4 alq = *(const LAS f32x4*)(alS + 4 * fq);
#pragma unroll
        for (int T = 0; T < 4; ++T) { O[T] = O[T] * alq;
            const bf16x8 B0 = pack8((f32x4){Vr[0][0][T], Vr[0][1][T], Vr[0][2][T], Vr[0][3][T]}, (f32x4){Vr[0][4][T], Vr[0][5][T], Vr[0][6][T], Vr[0][7][T]});
            const bf16x8 B1 = pack8((f32x4){Vr[1][0][T], Vr[1][1][T], Vr[1][2][T], Vr[1][3][T]}, (f32x4){Vr[1][4][T], Vr[1][5][T], Vr[1][6][T], Vr[1][7][T]});
            O[T] = MFMA16(P0, B0, O[T]); O[T] = MFMA16(P1, B1, O[T]); }
        asm volatile("" ::: "memory");
    }
    l += __shfl_xor(l, 16); l += __shfl_xor(l, 32);
    { LAS float* cw = comb + wid * 1056;
      if (fq == 0) { cw[fr] = m; cw[16 + fr] = l; }
#pragma unroll
      for (int T = 0; T < 4; ++T)
#pragma unroll
          for (int r = 0; r < 4; ++r) cw[32 + (4 * fq + r) * 64 + 4 * fr + T] = O[T][r]; }
    LDS_WAIT(); __syncthreads();
    { const int i = tid >> 5, d2 = (tid & 31) * 2; float mm = -INFINITY;
#pragma unroll
      for (int w = 0; w < 8; ++w) mm = fmaxf(mm, comb[w * 1056 + i]);
      float L = 0.f, o0 = 0.f, o1 = 0.f;
#pragma unroll
      for (int w = 0; w < 8; ++w) { const float f = __builtin_amdgcn_exp2f(comb[w * 1056 + i] - mm); L += comb[w * 1056 + 16 + i] * f; o0 += comb[w * 1056 + 32 + i * 64 + d2] * f; o1 += comb[w * 1056 + 32 + i * 64 + d2 + 1] * f; }
      const float rl = 1.0f / L;
      *(unsigned*)(CAT + (size_t)(rowq0 + i) * D + h * HD + d2) = pk2(o0 * rl, o1 * rl);
      float sq = (o0 * rl) * (o0 * rl) + (o1 * rl) * (o1 * rl);
      sq += __shfl_xor(sq, 1); sq += __shfl_xor(sq, 2); sq += __shfl_xor(sq, 4); sq += __shfl_xor(sq, 8); sq += __shfl_xor(sq, 16);
      if ((tid & 31) == 0) SSQ[(size_t)(rowq0 + i) * 8 + h] = sq; }
    LDS_WAIT(); __syncthreads();
}
DI void sgdn_unit(int b, int h, const bf16* BQKV, const float* SM, float a_log, float dt_bias, const float* convw, const float* st_conv, const float* st_S, const bf16* BZ, const float* g_b_out, bf16* CAT, float* out_conv, float* out_S, LAS unsigned char* L, int lane) {
    asm volatile("" : "+v"(lane));
    LAS float* qs = (LAS float*)L; LAS float* ks = qs + DS * 64; LAS float* vs = ks + DS * 64;
    const int row0 = MP + b * DS;
#pragma unroll
    for (int type = 0; type < 3; ++type) { const int cb = type * WB + h * HD + lane; float x[DS + 3];
#pragma unroll
        for (int j = 0; j < 3; ++j) x[j] = st_conv[(size_t)(b * 3 + j) * 1152 + cb];
#pragma unroll
        for (int t = 0; t < DS; ++t) x[3 + t] = bf2f(BQKV[(size_t)(row0 + t) * 1152 + cb]);
        const float w0 = convw[cb], w1 = convw[1152 + cb], w2 = convw[2 * 1152 + cb], w3 = convw[3 * 1152 + cb];
#pragma unroll
        for (int j = 0; j < 3; ++j) out_conv[(size_t)(b * 3 + j) * 1152 + cb] = x[DS + j];
#pragma unroll
        for (int t = 0; t < DS; ++t) { const float y = pg8::silu_f(w0 * x[t] + w1 * x[t + 1] + w2 * x[t + 2] + w3 * x[t + 3]);
            if (type == 2) vs[t * 64 + lane] = y;
            else { const float rn = 1.0f / sqrtf(wave_sum(y * y) + 1e-6f); if (type == 0) qs[t * 64 + lane] = y * rn * 0.125f; else ks[t * 64 + lane] = y * rn; } }
        asm volatile("" ::: "memory"); }
    LDS_WAIT(); asm volatile("" ::: "memory");
    float S[64];
#pragma unroll
    for (int d = 0; d < 64; ++d) S[d] = st_S[((size_t)(b * NHB + h) * 64 + d) * 64 + lane];
    const float gbo = g_b_out[lane];
    for (int t = 0; t < DS; ++t) {
        const float a = __expf(gdn_decay_f(SM[(size_t)(6 + h) * M + row0 + t], a_log, dt_bias)), beta = sigmoid_f(SM[(size_t)(12 + h) * M + row0 + t]);
        float r = 0.f;
#pragma unroll
        for (int d4 = 0; d4 < 16; ++d4) { const f32x4 kv = *(const LAS f32x4*)(ks + t * 64 + 4 * d4); r += S[4 * d4] * kv.x + S[4 * d4 + 1] * kv.y + S[4 * d4 + 2] * kv.z + S[4 * d4 + 3] * kv.w; }
        const float vt = vs[t * 64 + lane];
        const float uu = beta * (vt - a * r); float o = 0.f;
#pragma unroll
        for (int d4 = 0; d4 < 16; ++d4) { const f32x4 kv = *(const LAS f32x4*)(ks + t * 64 + 4 * d4); const f32x4 qv = *(const LAS f32x4*)(qs + t * 64 + 4 * d4);
            S[4 * d4] = a * S[4 * d4] + kv.x * uu; S[4 * d4 + 1] = a * S[4 * d4 + 1] + kv.y * uu; S[4 * d4 + 2] = a * S[4 * d4 + 2] + kv.z * uu; S[4 * d4 + 3] = a * S[4 * d4 + 3] + kv.w * uu;
            o += S[4 * d4] * qv.x + S[4 * d4 + 1] * qv.y + S[4 * d4 + 2] * qv.z + S[4 * d4 + 3] * qv.w; }
        const float rs = 1.0f / sqrtf(wave_sum(o * o) * (1.f / 64.f) + 1e-6f);
        const float z = bf2f(BZ[(size_t)(row0 + t) * WB + h * HD + lane]);
        CAT[(size_t)(row0 + t) * D + WA + h * HD + lane] = f2bf(o * rs * gbo * z);
    }
#pragma unroll
    for (int d = 0; d < 64; ++d) out_S[((size_t)(b * NHB + h) * 64 + d) * 64 + lane] = S[d];
    LDS_WAIT(); asm volatile("" ::: "memory");
}
#define CONV_LOAD(xw, type, c16) do { const int cb_ = (type) * WB + h * HD; _Pragma("unroll") for (int q_ = 0; q_ < 2; ++q_) _Pragma("unroll") for (int tap_ = 0; tap_ < 4; ++tap_) { \
        const int tr_ = 64 * n + lane - 3 + tap_; xw[q_][tap_] = (v4u){0u, 0u, 0u, 0u}; if (tr_ >= 0) xw[q_][tap_] = *(const v4u*)(BQKV + (size_t)(row - 3 + tap_) * 1152 + cb_ + (2 * (c16) + q_) * 8); } } while (0)
DI float conv_slab(const v4u (&xw)[2][4], LAS bf16* buf, LAS bf16* bufT, int mode  , int type, int h, int c16, int lane, const float* convw, float* out_conv_b) {
    const int cb = type * WB + h * HD; float ss = 0.f;
#pragma unroll
    for (int q = 0; q < 2; ++q) { const int c8 = 2 * c16 + q; float a[8];
#pragma unroll
        for (int e = 0; e < 8; ++e) a[e] = 0.f;
#pragma unroll
        for (int tap = 0; tap < 4; ++tap) { const v4u w4 = xw[q][tap];
            const float xs[8] = {bflo(w4.x), bfhi(w4.x), bflo(w4.y), bfhi(w4.y), bflo(w4.z), bfhi(w4.z), bflo(w4.w), bfhi(w4.w)};
            typedef const __attribute__((address_space(4))) f32x4* cw4_t;
            const f32x4 w0 = *(cw4_t)(convw + tap * 1152 + cb + c8 * 8), w1 = *(cw4_t)(convw + tap * 1152 + cb + c8 * 8 + 4);
            a[0] += w0.x * xs[0]; a[1] += w0.y * xs[1]; a[2] += w0.z * xs[2]; a[3] += w0.w * xs[3]; a[4] += w1.x * xs[4]; a[5] += w1.y * xs[5]; a[6] += w1.z * xs[6]; a[7] += w1.w * xs[7];
            if (tap == 3 && out_conv_b && lane >= 61) { float* op = out_conv_b + (size_t)(lane - 61) * 1152 + cb + c8 * 8; *(f32x4*)op = (f32x4){xs[0], xs[1], xs[2], xs[3]}; *(f32x4*)(op + 4) = (f32x4){xs[4], xs[5], xs[6], xs[7]}; } }
#pragma unroll
        for (int e = 0; e < 8; ++e) { a[e] = pg8::silu_f(a[e]); ss += a[e] * a[e]; }
        v4u w; w.x = pk2(a[0], a[1]); w.y = pk2(a[2], a[3]); w.z = pk2(a[4], a[5]); w.w = pk2(a[6], a[7]);
        if (mode & 1) *(LAS v4u*)(buf + lane * 64 + 8 * c8) = w;
        if (mode & 2) {
            bufT[(8 * c8 + 0) * 64 + lane] = (bf16)(w.x & 0xffffu); bufT[(8 * c8 + 1) * 64 + lane] = (bf16)(w.x >> 16); bufT[(8 * c8 + 2) * 64 + lane] = (bf16)(w.y & 0xffffu); bufT[(8 * c8 + 3) * 64 + lane] = (bf16)(w.y >> 16);
            bufT[(8 * c8 + 4) * 64 + lane] = (bf16)(w.z & 0xffffu); bufT[(8 * c8 + 5) * 64 + lane] = (bf16)(w.z >> 16); bufT[(8 * c8 + 6) * 64 + lane] = (bf16)(w.w & 0xffffu); bufT[(8 * c8 + 7) * 64 + lane] = (bf16)(w.w >> 16); } }
    return ss;
}
DI float conv_rows(v4u (&xa)[2][4], LAS bf16* buf, LAS bf16* bufT, int mode, int type, int ntype, int h, int n, int row, int lane, const bf16* BQKV, const float* convw, float* out_conv_b  ) {
    v4u xb[2][4]; float ss = 0.f;
    CONV_LOAD(xb, type, 1); ss += conv_slab(xa, buf, bufT, mode, type, h, 0, lane, convw, out_conv_b);
    CONV_LOAD(xa, type, 2); ss += conv_slab(xb, buf, bufT, mode, type, h, 1, lane, convw, out_conv_b);
    CONV_LOAD(xb, type, 3); ss += conv_slab(xa, buf, bufT, mode, type, h, 2, lane, convw, out_conv_b);
    if (ntype >= 0) CONV_LOAD(xa, ntype, 0);
    ss += conv_slab(xb, buf, bufT, mode, type, h, 3, lane, convw, out_conv_b);
    return ss;
}
#define CONV_LOAD2(x, type) do { const int cb_ = (type) * WB + h * HD + 8 * (lane & 7); const int tb_ = 8 * (lane >> 3) - 3; _Pragma("unroll") for (int i_ = 0; i_ < 11; ++i_) { \
        const int tr_ = 64 * n + tb_ + i_; x[i_] = *(const v4u*)(BQKV + (size_t)(row0 + (tr_ < 0 ? 0 : tb_ + i_)) * 1152 + cb_); if (tr_ < 0) x[i_] = (v4u){0u, 0u, 0u, 0u}; } } while (0)
DI float conv_rows2(const v4u (&x)[11], LAS bf16* buf, LAS bf16* bufT, int mode, int type, int h, int lane, const float* convw, float* out_conv_b) {
    const int g = lane >> 3, c = lane & 7; const int cb = type * WB + h * HD + 8 * c;
    f32x4 wl[4], wh[4];
#pragma unroll
    for (int tap = 0; tap < 4; ++tap) { wl[tap] = *(const f32x4*)(convw + tap * 1152 + cb); wh[tap] = *(const f32x4*)(convw + tap * 1152 + cb + 4); }
    unsigned ow[8][4]; float ss[8];
#pragma unroll
    for (int j = 0; j < 8; ++j) ss[j] = 0.f;
#pragma unroll
    for (int wi = 0; wi < 4; ++wi) { float xl[11], xh[11];
#pragma unroll
        for (int i = 0; i < 11; ++i) { const unsigned w = x[i][wi]; xl[i] = bflo(w); xh[i] = bfhi(w); }
        float w0[4], w1[4];
#pragma unroll
        for (int tap = 0; tap < 4; ++tap) { w0[tap] = wi < 2 ? wl[tap][2 * (wi & 1)] : wh[tap][2 * (wi & 1)]; w1[tap] = wi < 2 ? wl[tap][2 * (wi & 1) + 1] : wh[tap][2 * (wi & 1) + 1]; }
#pragma unroll
        for (int j = 0; j < 8; ++j) { float a0 = 0.f, a1 = 0.f;
#pragma unroll
            for (int tap = 0; tap < 4; ++tap) { a0 += w0[tap] * xl[j + tap]; a1 += w1[tap] * xh[j + tap]; }
            a0 = pg8::silu_f(a0); a1 = pg8::silu_f(a1); ss[j] += a0 * a0 + a1 * a1; ow[j][wi] = pk2(a0, a1); } }
    if (out_conv_b && g == 7) {
#pragma unroll
        for (int j3 = 0; j3 < 3; ++j3) { const v4u w4 = x[8 + j3]; float* op = out_conv_b + (size_t)j3 * 1152 + cb;
            *(f32x4*)op = (f32x4){bflo(w4.x), bfhi(w4.x), bflo(w4.y), bfhi(w4.y)}; *(f32x4*)(op + 4) = (f32x4){bflo(w4.z), bfhi(w4.z), bflo(w4.w), bfhi(w4.w)}; } }
    if (mode & 1) {
#pragma unroll
        for (int j = 0; j < 8; ++j) { v4u w; w.x = ow[j][0]; w.y = ow[j][1]; w.z = ow[j][2]; w.w = ow[j][3]; *(LAS v4u*)(buf + (8 * g + j) * 64 + 8 * c) = w; } }
    if (mode & 2) {
#pragma unroll
        for (int e = 0; e < 8; ++e) { const int wi = e >> 1; v4u w;
            if (e & 1) { w.x = (ow[0][wi] >> 16) | (ow[1][wi] & 0xffff0000u); w.y = (ow[2][wi] >> 16) | (ow[3][wi] & 0xffff0000u); w.z = (ow[4][wi] >> 16) | (ow[5][wi] & 0xffff0000u); w.w = (ow[6][wi] >> 16) | (ow[7][wi] & 0xffff0000u); }
            else { w.x = (ow[0][wi] & 0xffffu) | (ow[1][wi] << 16); w.y = (ow[2][wi] & 0xffffu) | (ow[3][wi] << 16); w.z = (ow[4][wi] & 0xffffu) | (ow[5][wi] << 16); w.w = (ow[6][wi] & 0xffffu) | (ow[7][wi] << 16); }
            *(LAS v4u*)(bufT + (8 * c + e) * 64 + 8 * g) = w; } }
    float my = 0.f;
#pragma unroll
    for (int j = 0; j < 8; ++j) { float t = ss[j]; t += __shfl_xor(t, 1); t += __shfl_xor(t, 2); t += __shfl_xor(t, 4); my = (c == j) ? t : my; }
    return my;
}
__host__ __device__ constexpr int TRIG(int i) { return i <= 0 ? 0 : (((i - 1) >> 2) + 1) * ((i - 1) - 2 * ((i - 1) >> 2)); }
static_assert(TRIG(1) == 0 && TRIG(2) == 1 && TRIG(5) == 4 && TRIG(6) == 6 && TRIG(64) == 528, "triangular packing");
DI void prep_unit(int u, const bf16* BQKV, const float* SM, const float* a_log, const float* dt_bias, const float* convw, unsigned char* prep, float* GLarr, float* out_conv, LAS unsigned char* L, int lane) {
    asm volatile("" : "+v"(lane));
    const int h = u % NHB, bn = u / NHB, n = bn % NCH, b = bn / NCH; const int row0 = b * SEQ + 64 * n, row = row0 + lane; const int fr = lane & 15, fq = lane >> 4;
    LAS bf16* B1 = (LAS bf16*)L; LAS bf16* B2 = (LAS bf16*)(L + 8192); LAS float* Abuf = (LAS float*)(L + 8192);
    LAS float* Gs = (LAS float*)(L + 16640); LAS float* Bs = Gs + 64; LAS float* Ks = Gs + 128; LAS float* RKs = Gs + 192; LAS float* RQs = Gs + 256;
    unsigned char* slot = prep + ((size_t)(b * NHB + h) * NCH + n) * 40960;
    unsigned char* dummy = (unsigned char*)GLarr + 524288;
    float* ocb = (n == NCH - 1) ? out_conv + (size_t)b * 3 * 1152 : nullptr;
    const float gl = gdn_decay_f(SM[(size_t)(6 + h) * M + row], a_log[h], dt_bias[h]), beta = sigmoid_f(SM[(size_t)(12 + h) * M + row]);
    const float G = wave_incl_scan(gl, lane), eG = __expf(G), Gtot = __shfl(G, 63);
    if (lane == 0) GLarr[(b * NHB + h) * NCH + n] = __expf(Gtot);
    const int pl = pinv(lane);
    v4u xa[2][4]; CONV_LOAD(xa, 1, 0);
    const float rnk = 1.0f / sqrtf(conv_rows(xa, B1, B1, 1, 1, 0, h, n, row, lane, BQKV, convw, ocb) + 1e-6f);
    const float rnq = 0.125f / sqrtf(conv_rows(xa, B2, B2, 1, 0, -1, h, n, row, lane, BQKV, convw, ocb) + 1e-6f);
    Gs[lane] = G; Bs[lane] = beta; Ks[lane] = beta * eG * rnk; RKs[lane] = rnk; RQs[lane] = rnq;
    LDS_WAIT(); asm volatile("" ::: "memory");
    {
      const float ksc = rnk * __expf(Gtot - G), qsc = rnq * eG;
      unsigned char* kd = slot + 32768 + (pl & 7) * 2; const int pc = pl >> 3;
#pragma unroll 1
      for (int c8 = 0; c8 < 8; ++c8) { const v4u w = *(const LAS v4u*)(B1 + lane * 64 + 8 * c8); unsigned char* p = kd + c8 * 8 * 128; const int sw = (4 * c8) & 7;
          *(bf16*)(p + 0 * 128 + ((pc ^ (sw + 0)) << 4)) = f2bf(bflo(w.x) * ksc); *(bf16*)(p + 1 * 128 + ((pc ^ (sw + 0)) << 4)) = f2bf(bfhi(w.x) * ksc);
          *(bf16*)(p + 2 * 128 + ((pc ^ (sw + 1)) << 4)) = f2bf(bflo(w.y) * ksc); *(bf16*)(p + 3 * 128 + ((pc ^ (sw + 1)) << 4)) = f2bf(bfhi(w.y) * ksc);
          *(bf16*)(p + 4 * 128 + ((pc ^ (sw + 2)) << 4)) = f2bf(bflo(w.z) * ksc); *(bf16*)(p + 5 * 128 + ((pc ^ (sw + 2)) << 4)) = f2bf(bfhi(w.z) * ksc);
          *(bf16*)(p + 6 * 128 + ((pc ^ (sw + 3)) << 4)) = f2bf(bflo(w.w) * ksc); *(bf16*)(p + 7 * 128 + ((pc ^ (sw + 3)) << 4)) = f2bf(bfhi(w.w) * ksc); }
#pragma unroll 1
      for (int g = 0; g < 8; ++g) { const int d0 = 32 * (g >> 2) + 4 * (g & 3); const v2u a = *(const LAS v2u*)(B2 + lane * 64 + d0), c = *(const LAS v2u*)(B2 + lane * 64 + d0 + 16);
          v4u w; w.x = pk2(bflo(a.x) * qsc, bfhi(a.x) * qsc); w.y = pk2(bflo(a.y) * qsc, bfhi(a.y) * qsc); w.z = pk2(bflo(c.x) * qsc, bfhi(c.x) * qsc); w.w = pk2(bflo(c.y) * qsc, bfhi(c.y) * qsc);
          *(v4u*)(slot + 16384 + lane * 128 + ((g ^ ((lane >> 1) & 7)) << 4)) = w; } }
    { bf16x8 kf[4][2], qf[4][2];
#pragma unroll
      for (int mt = 0; mt < 4; ++mt)
#pragma unroll
          for (int ks = 0; ks < 2; ++ks) { kf[mt][ks] = *(const LAS bf16x8*)(B1 + (16 * mt + fr) * 64 + 32 * ks + 8 * fq); qf[mt][ks] = *(const LAS bf16x8*)(B2 + (16 * mt + fr) * 64 + 32 * ks + 8 * fq); }
      LDS_WAIT(); asm volatile("" : "+v"(qf[0][0]), "+v"(qf[1][0]), "+v"(qf[2][0]), "+v"(qf[3][0]), "+v"(qf[0][1]), "+v"(qf[1][1]), "+v"(qf[2][1]), "+v"(qf[3][1]) :: "memory");
#pragma unroll
      for (int mi = 0; mi < 4; ++mi) { const f32x4 Gi = *(const LAS f32x4*)(Gs + 16 * mi + 4 * fq), Bi = *(const LAS f32x4*)(Bs + 16 * mi + 4 * fq), RKi = *(const LAS f32x4*)(RKs + 16 * mi + 4 * fq), RQi = *(const LAS f32x4*)(RQs + 16 * mi + 4 * fq);
#pragma unroll
          for (int nj = 0; nj < 4; ++nj) { const int j = 16 * nj + fr; const int pj = pinv(j); unsigned char* qkp = slot + 24576 + (16 * mi + 4 * fq) * 128 + (pj & 7) * 2; const int pjc = pj >> 3, swq = (8 * mi + 2 * fq) & 7;
              if (nj <= mi) { const float Gj = Gs[j], RKj = RKs[j];
                  f32x4 a = MFMA16(kf[mi][0], kf[nj][0], ((f32x4){0.f, 0.f, 0.f, 0.f})); a = MFMA16(kf[mi][1], kf[nj][1], a);
                  f32x4 c = MFMA16(qf[mi][0], kf[nj][0], ((f32x4){0.f, 0.f, 0.f, 0.f})); c = MFMA16(qf[mi][1], kf[nj][1], c);
#pragma unroll
                  for (int r = 0; r < 4; ++r) { const int i = 16 * mi + 4 * fq + r; const float dec = __expf(fminf(Gi[r] - Gj, 0.f)) * RKj;
                      const int nn = i - 1, qq = nn >> 2, tg = (qq + 1) * (nn - 2 * qq);
                      if (nj < mi || j < ((i + 3) & ~3)) Abuf[4 * tg + j] = (j < i) ? Bi[r] * RKi[r] * a[r] * dec : 0.f;
                      *(bf16*)(qkp + r * 128 + ((pjc ^ (swq + (r >> 1))) << 4)) = f2bf((j <= i) ? RQi[r] * c[r] * dec : 0.f); }
              } else {
#pragma unroll
                  for (int r = 0; r < 4; ++r) *(bf16*)(qkp + r * 128 + ((pjc ^ (swq + (r >> 1))) << 4)) = (bf16)0; } } } }
    LDS_WAIT(); asm volatile("" ::: "memory");
    for (int pp = 0; pp < 2; ++pp) {
        const bool isk = (pp == 0);
        if (!isk) { CONV_LOAD(xa, 2, 0); (void)conv_rows(xa, B1, B1, 1, 2, -1, h, n, row, lane, BQKV, convw, ocb); LDS_WAIT(); asm volatile("" ::: "memory"); }
        const LAS float* scs = isk ? Ks : Bs;
        unsigned char* ob = isk ? slot + (pl & 7) * 2 : dummy + (lane & 7) * 2; const int pc = pl >> 3; const int rstep = isk ? 128 : 0;
        float x[64];
#pragma unroll
        for (int i = 0; i < 64; ++i) {
            float acc = scs[i] * bf2f(B1[i * 64 + lane]); float s0 = 0.f, s1 = 0.f, s2 = 0.f, s3 = 0.f;
#pragma unroll
            for (int j4 = 0; j4 < (i + 3) / 4; ++j4) { const f32x4 a = *(const LAS f32x4*)(Abuf + 4 * (TRIG(i) + j4));
                if (4 * j4 < i) s0 += a.x * x[4 * j4]; if (4 * j4 + 1 < i) s1 += a.y * x[4 * j4 + 1]; if (4 * j4 + 2 < i) s2 += a.z * x[4 * j4 + 2]; if (4 * j4 + 3 < i) s3 += a.w * x[4 * j4 + 3]; }
            acc -= (s0 + s1) + (s2 + s3);
            x[i] = acc; *(bf16*)(ob + i * rstep + ((pc ^ ((i >> 1) & 7)) << 4)) = f2bf(acc);
            if ((i & 7) == 7) asm volatile("" ::: "memory");
        }
        if (!isk) {
#pragma unroll
            for (int g = 0; g < 8; ++g) { const int t0 = 32 * (g >> 2) + 4 * (g & 3); v4u w; w.x = pk2(x[t0], x[t0 + 1]); w.y = pk2(x[t0 + 2], x[t0 + 3]); w.z = pk2(x[t0 + 16], x[t0 + 17]); w.w = pk2(x[t0 + 18], x[t0 + 19]);
                *(v4u*)(slot + 8192 + lane * 128 + ((g ^ ((lane >> 1) & 7)) << 4)) = w; } }
    }
    LDS_WAIT(); asm volatile("" ::: "memory");
}

typedef float f32x2s __attribute__((ext_vector_type(2))); typedef __bf16 bf16x2s __attribute__((ext_vector_type(2)));
DI unsigned pk2s(float lo, float hi) { const f32x2s v = {lo, hi}; const bf16x2s b = __builtin_convertvector(v, bf16x2s); return __builtin_bit_cast(unsigned, b); }
DI bf16x8 pack8s(const f32x4 a, const f32x4 b) { v4u p; p.x = pk2s(a[0], a[1]); p.y = pk2s(a[2], a[3]); p.z = pk2s(b[0], b[1]); p.w = pk2s(b[2], b[3]); return __builtin_bit_cast(bf16x8, p); }
DI void prep_unit2(int u, const bf16* BQKV, const float* SM, const float* a_log, const float* dt_bias, const float* convw, unsigned char* prep, float* GLarr, float* out_conv, LAS unsigned char* L, int lane) {
    asm volatile("" : "+v"(lane));
    const int h = u % NHB, bn = u / NHB, n = bn % NCH, b = bn / NCH; const int row0 = b * SEQ + 64 * n, row = row0 + lane; const int fr = lane & 15, fq = lane >> 4;
    LAS bf16* B1 = (LAS bf16*)L; LAS bf16* B2 = (LAS bf16*)(L + 8192);
    LAS float* Gs = (LAS float*)(L + 16384); LAS float* Bs = Gs + 64; LAS float* Ks = Gs + 128; LAS float* RKs = Gs + 192; LAS float* RQs = Gs + 256; LAS float* BRs = Gs + 320; LAS float* KDs = Gs + 384;
    unsigned char* slot = prep + ((size_t)(b * NHB + h) * NCH + n) * 40960;
    float* ocb = (n == NCH - 1) ? out_conv + (size_t)b * 3 * 1152 : nullptr;
    const float gl = gdn_decay_f(SM[(size_t)(6 + h) * M + row], a_log[h], dt_bias[h]), beta = sigmoid_f(SM[(size_t)(12 + h) * M + row]);
    const float G = wave_incl_scan(gl, lane), eG = __expf(G), Gtot = __shfl(G, 63);
    if (lane == 0) GLarr[(b * NHB + h) * NCH + n] = __expf(Gtot);
    v4u xq[11], xk[11]; CONV_LOAD2(xq, 0); CONV_LOAD2(xk, 1);
    const float rnq = 0.125f / sqrtf(conv_rows2(xq, B2, B2, 1, 0, h, lane, convw, ocb) + 1e-6f);
    LDS_WAIT(); asm volatile("" ::: "memory");
    bf16x8 kf[4][2], qf[4][2];
#pragma unroll
    for (int mt = 0; mt < 4; ++mt)
#pragma unroll
        for (int ks = 0; ks < 2; ++ks) qf[mt][ks] = *(const LAS bf16x8*)(B2 + (16 * mt + fr) * 64 + 32 * ks + 8 * fq);
    { Gs[lane] = rnq * eG; LDS_WAIT(); asm volatile("" ::: "memory");
      const int r8 = lane >> 3, cd = lane & 7, d0 = 32 * (cd >> 2) + 4 * (cd & 3);
#pragma unroll 2
      for (int i = 0; i < 8; ++i) { const int t = 8 * i + r8; const float qsc = Gs[t]; const v2u a = *(const LAS v2u*)(B2 + t * 64 + d0), c = *(const LAS v2u*)(B2 + t * 64 + d0 + 16);
          v4u w; w.x = pk2(bflo(a.x) * qsc, bfhi(a.x) * qsc); w.y = pk2(bflo(a.y) * qsc, bfhi(a.y) * qsc); w.z = pk2(bflo(c.x) * qsc, bfhi(c.x) * qsc); w.w = pk2(bflo(c.y) * qsc, bfhi(c.y) * qsc);
          *(v4u*)(slot + 16384 + t * 128 + ((cd ^ ((t >> 1) & 7)) << 4)) = w; } }
    LDS_WAIT(); asm volatile("" : "+v"(qf[0][0]), "+v"(qf[1][0]), "+v"(qf[2][0]), "+v"(qf[3][0]), "+v"(qf[0][1]), "+v"(qf[1][1]), "+v"(qf[2][1]), "+v"(qf[3][1]) :: "memory");
    const float rnk = 1.0f / sqrtf(conv_rows2(xk, B1, B2, 3, 1, h, lane, convw, ocb) + 1e-6f);
    Gs[lane] = G; Bs[lane] = beta; Ks[lane] = beta * eG * rnk; RKs[lane] = rnk; RQs[lane] = rnq; BRs[lane] = beta * rnk; KDs[lane] = rnk * __expf(Gtot - G);
    LDS_WAIT(); asm volatile("" ::: "memory");
#pragma unroll
    for (int mt = 0; mt < 4; ++mt)
#pragma unroll
        for (int ks = 0; ks < 2; ++ks) kf[mt][ks] = *(const LAS bf16x8*)(B1 + (16 * mt + fr) * 64 + 32 * ks + 8 * fq);
    LDS_WAIT(); asm volatile("" : "+v"(kf[0][0]), "+v"(kf[1][0]), "+v"(kf[2][0]), "+v"(kf[3][0]), "+v"(kf[0][1]), "+v"(kf[1][1]), "+v"(kf[2][1]), "+v"(kf[3][1]) :: "memory");
    {
      const int r8 = lane >> 3, cd = lane & 7, t0 = 32 * (cd >> 2) + 4 * (cd & 3);
      const f32x4 sa = *(const LAS f32x4*)(KDs + t0), sb = *(const LAS f32x4*)(KDs + t0 + 16);
#pragma unroll 2
      for (int i = 0; i < 8; ++i) { const int d = 8 * i + r8; const v2u a = *(const LAS v2u*)(B2 + d * 64 + t0), c = *(const LAS v2u*)(B2 + d * 64 + t0 + 16);
          v4u w; w.x = pk2(bflo(a.x) * sa.x, bfhi(a.x) * sa.y); w.y = pk2(bflo(a.y) * sa.z, bfhi(a.y) * sa.w); w.z = pk2(bflo(c.x) * sb.x, bfhi(c.x) * sb.y); w.w = pk2(bflo(c.y) * sb.z, bfhi(c.y) * sb.w);
          *(v4u*)(slot + 32768 + d * 128 + ((cd ^ ((d >> 1) & 7)) << 4)) = w; } }
    const f32x4 z4 = (f32x4){0.f, 0.f, 0.f, 0.f};
#pragma unroll
    for (int mi = 0; mi < 4; ++mi) { const f32x4 Gi = *(const LAS f32x4*)(Gs + 16 * mi + 4 * fq), RQi = *(const LAS f32x4*)(RQs + 16 * mi + 4 * fq);
#pragma unroll
        for (int nj = 0; nj < 4; ++nj) { const int j = 16 * nj + fr; const int pj = pinv(j); unsigned char* qkp = slot + 24576 + (16 * mi + 4 * fq) * 128 + (pj & 7) * 2; const int pjc = pj >> 3, swq = (8 * mi + 2 * fq) & 7;
            if (nj <= mi) { const float Gj = Gs[j], RKj = RKs[j];
                f32x4 c = MFMA16(qf[mi][0], kf[nj][0], z4); c = MFMA16(qf[mi][1], kf[nj][1], c);
#pragma unroll
                for (int r = 0; r < 4; ++r) { const int i = 16 * mi + 4 * fq + r; const float dec = __expf(fminf(Gi[r] - Gj, 0.f)) * RKj;
                    *(bf16*)(qkp + r * 128 + ((pjc ^ (swq + (r >> 1))) << 4)) = f2bf((j <= i) ? RQi[r] * c[r] * dec : 0.f); }
            } else {
#pragma unroll
                for (int r = 0; r < 4; ++r) *(bf16*)(qkp + r * 128 + ((pjc ^ (swq + (r >> 1))) << 4)) = (bf16)0; } } }
    bf16x8 Aop1, Aop2, Aop3a, Aop3b;
    { LAS float* DG = (LAS float*)B1;
      f32x4 Nt[4][4];
#pragma unroll
      for (int mi = 0; mi < 4; ++mi) { const int i = 16 * mi + fr; const float bri = BRs[i], Gi = Gs[i];
#pragma unroll
          for (int nj = 0; nj <= mi; ++nj) { const f32x4 Gj = *(const LAS f32x4*)(Gs + 16 * nj + 4 * fq), RKj = *(const LAS f32x4*)(RKs + 16 * nj + 4 * fq);
              f32x4 t = MFMA16(kf[nj][0], kf[mi][0], z4); t = MFMA16(kf[nj][1], kf[mi][1], t);
              f32x4 v;
#pragma unroll
              for (int r = 0; r < 4; ++r) { const int j = 16 * nj + 4 * fq + r; v[r] = (j < i) ? bri * RKj[r] * __expf(fminf(Gi - Gj[r], 0.f)) * t[r] : 0.f; }
              if (nj == mi) *(LAS f32x4*)(DG + mi * 256 + fr * 16 + 4 * fq) = v; else Nt[mi][nj] = -v; } }
      Aop1 = pack8(Nt[1][0], z4); Aop2 = pack8(Nt[2][0], Nt[2][1]); Aop3a = pack8(Nt[3][0], Nt[3][1]); Aop3b = pack8(Nt[3][2], z4); }
    LDS_WAIT(); asm volatile("" ::: "memory");
    bf16x8 Dop[4];
    { const LAS float* DG = (const LAS float*)B1 + fq * 256; LAS bf16* DIb = (LAS bf16*)(L + 4096);
      float x[16];
#pragma unroll
      for (int r = 0; r < 16; ++r) { float acc = (r == fr) ? 1.f : 0.f;
#pragma unroll
          for (int j4 = 0; j4 < (r + 3) / 4; ++j4) { const f32x4 a = *(const LAS f32x4*)(DG + r * 16 + 4 * j4);
              if (4 * j4 < r) acc -= a.x * x[4 * j4]; if (4 * j4 + 1 < r) acc -= a.y * x[4 * j4 + 1]; if (4 * j4 + 2 < r) acc -= a.z * x[4 * j4 + 2]; if (4 * j4 + 3 < r) acc -= a.w * x[4 * j4 + 3]; }
          x[r] = acc; DIb[fq * 256 + r * 16 + fr] = f2bf(acc); }
      LDS_WAIT(); asm volatile("" ::: "memory");
#pragma unroll
      for (int m = 0; m < 4; ++m) { const v2u d = *(const LAS v2u*)(DIb + m * 256 + fr * 16 + 4 * fq); v4u w; w.x = d.x; w.y = d.y; w.z = 0u; w.w = 0u; Dop[m] = __builtin_bit_cast(bf16x8, w); }
      LDS_WAIT(); asm volatile("" : "+v"(Dop[0]), "+v"(Dop[1]), "+v"(Dop[2]), "+v"(Dop[3]) :: "memory"); }
#define PREP_SOLVE(srcT, SC, STORE) do { _Pragma("unroll") for (int ct = 0; ct < 4; ++ct) { const int col = 16 * ct + fr; f32x4 X[4]; \
        _Pragma("unroll") for (int m = 0; m < 4; ++m) { const v2u rw = *(const LAS v2u*)((srcT) + col * 64 + 16 * m + 4 * fq); const f32x4 sc = *(const LAS f32x4*)((SC) + 16 * m + 4 * fq); \
            X[m] = (f32x4){bflo(rw.x) * sc.x, bfhi(rw.x) * sc.y, bflo(rw.y) * sc.z, bfhi(rw.y) * sc.w}; } \
        X[0] = MFMA16(Dop[0], pack8s(X[0], z4), z4); \
        const bf16x8 b0 = pack8s(X[0], z4); \
        X[1] = MFMA16(Aop1, b0, X[1]); X[1] = MFMA16(Dop[1], pack8s(X[1], z4), z4); \
        const bf16x8 b01 = pack8s(X[0], X[1]); \
        X[2] = MFMA16(Aop2, b01, X[2]); X[2] = MFMA16(Dop[2], pack8s(X[2], z4), z4); \
        X[3] = MFMA16(Aop3a, b01, X[3]); X[3] = MFMA16(Aop3b, pack8s(X[2], z4), X[3]); X[3] = MFMA16(Dop[3], pack8s(X[3], z4), z4); \
        _Pragma("unroll") for (int m = 0; m < 4; ++m) { STORE; } } } while (0)
#define PREP_STORE_W do { const int pd_ = pinv(col); _Pragma("unroll") for (int r = 0; r < 4; ++r) { const int t_ = 16 * m + 4 * fq + r; \
        *(bf16*)(slot + t_ * 128 + (((pd_ >> 3) ^ ((t_ >> 1) & 7)) << 4) + (pd_ & 7) * 2) = (bf16)(pk2s(X[m][r], 0.f) & 0xffffu); } } while (0)
#define PREP_STORE_UV do { v2u w_; w_.x = pk2s(X[m][0], X[m][1]); w_.y = pk2s(X[m][2], X[m][3]); \
        *(v2u*)(slot + 8192 + col * 128 + (((4 * (m >> 1) + fq) ^ ((col >> 1) & 7)) << 4) + (m & 1) * 8) = w_; } while (0)
    v4u xv[11]; CONV_LOAD2(xv, 2);
    PREP_SOLVE(B2, Ks, PREP_STORE_W);
    (void)conv_rows2(xv, B1, B1, 2, 2, h, lane, convw, ocb);
    LDS_WAIT(); asm volatile("" ::: "memory");
    PREP_SOLVE(B1, Bs, PREP_STORE_UV);
#undef PREP_SOLVE
#undef PREP_STORE_W
#undef PREP_STORE_UV
    LDS_WAIT(); asm volatile("" ::: "memory");
}
DI void scan_unit(int bh, const unsigned char* prep, const float* GLarr, const bf16* BZ, const float* g_b_out, bf16* CAT, float* out_S, LAS unsigned char* lds, int tid, int lane, int wid) {
    asm volatile("" : "+v"(tid), "+v"(lane));
    const int b = bh / NHB, h = bh % NHB, rowbase = b * SEQ, fr = lane & 15, fq = lane >> 4, e0 = wid * 16;
    const unsigned char* src = prep + (size_t)bh * NCH * 40960;
    LAS bf16* obuf = (LAS bf16*)(lds + 122880);
    LAS unsigned char* bzs = lds + 139264;
#define SCAN_DMA(n, s) do { _Pragma("unroll") for (int i_ = 0; i_ < 5; ++i_) { const int p_ = wid + 8 * i_; \
        __builtin_amdgcn_global_load_lds((const unsigned*)(src + (size_t)(n) * 40960 + p_ * 1024 + lane * 16), (LAS unsigned*)(lds + (s) * 40960 + p_ * 1024), 16, 0, 0); } } while (0)
#define SCAN_SYNC() do { asm volatile("s_waitcnt vmcnt(0) lgkmcnt(0)" ::: "memory"); __builtin_amdgcn_s_barrier(); asm volatile("" ::: "memory"); } while (0)
#define SCAN_SYNC5() do { asm volatile("s_waitcnt vmcnt(5) lgkmcnt(0)" ::: "memory"); __builtin_amdgcn_s_barrier(); asm volatile("" ::: "memory"); } while (0)
#define SCAN_BZDMA(nc) do { _Pragma("unroll") for (int i_ = 0; i_ < 2; ++i_) { const int t_ = 16 * (wid - 4) + 8 * i_ + (lane >> 3);        \
            __builtin_amdgcn_global_load_lds((const unsigned*)(BZ + ((size_t)rowbase + 64 * (nc) + t_) * WB + h * HD + 8 * (lane & 7)), (LAS unsigned*)(bzs + ((nc) & 1) * 8192 + (16 * (wid - 4) + 8 * i_) * 128), 16, 0, 0); } } while (0)
#define SCAN_POST(nc) do { const LAS bf16* ob_ = obuf + ((nc) & 1) * 4096; const LAS unsigned char* bz_ = bzs + ((nc) & 1) * 8192; const int c4_ = 4 * (lane & 15); \
        _Pragma("unroll") for (int i_ = 0; i_ < 4; ++i_) { const int t_ = 16 * (wid - 4) + 4 * i_ + (lane >> 4); const v2u ow_ = *(const LAS v2u*)(ob_ + t_ * 64 + c4_); \
            const float ox_ = bflo(ow_.x), oy_ = bfhi(ow_.x), oz_ = bflo(ow_.y), ow2_ = bfhi(ow_.y); \
            float ss_ = (ox_ * ox_ + oy_ * oy_) + (oz_ * oz_ + ow2_ * ow2_); ss_ += __shfl_xor(ss_, 1); ss_ += __shfl_xor(ss_, 2); ss_ += __shfl_xor(ss_, 4); ss_ += __shfl_xor(ss_, 8); \
            const float rs_ = 1.0f / sqrtf(ss_ * (1.f / 64.f) + 1e-6f); const size_t row_ = (size_t)rowbase + 64 * (nc) + t_; \
            const v2u z_ = *(const LAS v2u*)(bz_ + t_ * 128 + c4_ * 2); v2u w_; \
            w_.x = pk2(ox_ * rs_ * gbo.x * bflo(z_.x), oy_ * rs_ * gbo.y * bfhi(z_.x)); w_.y = pk2(oz_ * rs_ * gbo.z * bflo(z_.y), ow2_ * rs_ * gbo.w * bfhi(z_.y)); \
            *(v2u*)(CAT + row_ * D + WA + h * HD + c4_) = w_; } } while (0)
    LAS float* gls = (LAS float*)(lds + MISC_OFF + 1024);
    if (tid < NCH) gls[tid] = GLarr[bh * NCH + tid];
    const f32x4 gbo = *(const f32x4*)(g_b_out + 4 * (lane & 15));
    if (wid >= 4) { SCAN_BZDMA(0); SCAN_BZDMA(1); }
    SCAN_DMA(0, 0); SCAN_DMA(1, 1);
    SCAN_SYNC();
    const int swz = (fr >> 1) & 7;
    f32x4 S[4]; bf16x8 Sb[2];
#pragma unroll
    for (int mt = 0; mt < 4; ++mt) S[mt] = (f32x4){0.f, 0.f, 0.f, 0.f};
    Sb[0] = (bf16x8){0, 0, 0, 0, 0, 0, 0, 0}; Sb[1] = Sb[0];
    int slot = 0;
    for (int n = 0; n < NCH; ++n) {
        if (wid >= 4 && n > 0) { SCAN_POST(n - 1); asm volatile("s_waitcnt lgkmcnt(0)" ::: "memory"); if (n + 1 < NCH) SCAN_BZDMA(n + 1); }
        if (n + 2 < NCH) { const int s2 = (slot == 0) ? 2 : slot - 1; SCAN_DMA(n + 2, s2); }
        if (wid < 4) {
            const LAS unsigned char* base = lds + slot * 40960;
            const float gL = gls[n];
            const f32x4 z4 = (f32x4){0.f, 0.f, 0.f, 0.f};
            f32x4 U[4], O[4];
            const int c0 = (fq ^ swz) << 4, c1 = ((4 + fq) ^ swz) << 4;
#pragma unroll
            for (int mt = 0; mt < 4; ++mt) { const LAS unsigned char* rp = base + (16 * mt + fr) * 128;
                f32x4 P = MFMA16(*(const LAS bf16x8*)(rp + c0), Sb[0], z4); P = MFMA16(*(const LAS bf16x8*)(rp + c1), Sb[1], P);
                const v2u uv = *(const LAS v2u*)(base + 8192 + (e0 + fr) * 128 + (((4 * (mt >> 1) + fq) ^ (((e0 + fr) >> 1) & 7)) << 4) + (mt & 1) * 8);
                U[mt][0] = bflo(uv.x) - P[0]; U[mt][1] = bfhi(uv.x) - P[1]; U[mt][2] = bflo(uv.y) - P[2]; U[mt][3] = bfhi(uv.y) - P[3]; }
            bf16x8 Ub[2]; Ub[0] = pack8(U[0], U[1]); Ub[1] = pack8(U[2], U[3]);
#pragma unroll
            for (int mt = 0; mt < 4; ++mt) { const LAS unsigned char* rq = base + 16384 + (16 * mt + fr) * 128; const LAS unsigned char* rk = rq + 8192;
                f32x4 o = MFMA16(*(const LAS bf16x8*)(rq + c0), Sb[0], z4); o = MFMA16(*(const LAS bf16x8*)(rq + c1), Sb[1], o);
                o = MFMA16(*(const LAS bf16x8*)(rk + c0), Ub[0], o); o = MFMA16(*(const LAS bf16x8*)(rk + c1), Ub[1], o); O[mt] = o; }
#pragma unroll
            for (int mt = 0; mt < 4; ++mt) { const LAS unsigned char* rd = base + 32768 + (16 * mt + fr) * 128;
                f32x4 s = S[mt] * gL; s = MFMA16(*(const LAS bf16x8*)(rd + c0), Ub[0], s); s = MFMA16(*(const LAS bf16x8*)(rd + c1), Ub[1], s); S[mt] = s; }
            MFMA_SETTLE4(S[0], S[1], S[2], S[3]);
            Sb[0] = pack8(S[0], S[1]); Sb[1] = pack8(S[2], S[3]);
            LAS bf16* ob = obuf + (n & 1) * 4096;
            MFMA_SETTLE4(O[0], O[1], O[2], O[3]);
#pragma unroll
            for (int mt = 0; mt < 4; ++mt)
#pragma unroll
                for (int r = 0; r < 4; ++r) ob[(16 * mt + 4 * fq + r) * 64 + e0 + fr] = f2bf(O[mt][r]);
        }
        if (n + 2 < NCH) SCAN_SYNC5(); else SCAN_SYNC();
        slot = (slot == 2) ? 0 : slot + 1;
    }
    if (wid >= 4) { SCAN_POST(NCH - 1); }
    else {
#pragma unroll
        for (int mt = 0; mt < 4; ++mt)
#pragma unroll
            for (int r = 0; r < 4; ++r) out_S[((size_t)bh * 64 + 16 * mt + 4 * fq + r) * 64 + e0 + fr] = S[mt][r];
    }
    SCAN_SYNC();
#undef SCAN_DMA
#undef SCAN_SYNC
#undef SCAN_SYNC5
#undef SCAN_POST
#undef SCAN_BZDMA
}
__device__ __noinline__ void xcd_barrier_call(unsigned* bar, unsigned x, volatile LAS unsigned* st) { XcdBarrier b; b.bar = bar; b.x = x; b.st = st; xcd_barrier(b); }

struct OneUnit { int pm, pn;
    __device__ __forceinline__ bool next(int i, pg8::Unit& u) const { if (i) return false; u.pm = pm; u.pn = pn; return true; }
    __device__ __forceinline__ void a_ready(const pg8::Unit&) const {}
    __device__ __forceinline__ void done(const pg8::Unit&) const {} };
constexpr int NTAIL = 8, CW_TAIL = 98304;
DI void tail_meet(unsigned* cnt, int tid0, int target = NTAIL) {
    VM_WAIT(); __syncthreads();
    if (tid0 == 0) { __builtin_amdgcn_fence(__ATOMIC_RELEASE, "agent"); VM_WAIT(); __hip_atomic_fetch_add(cnt, 1u, RLX_AGENT);
        for (unsigned sp = 0; sp < (1u << 22); ++sp) { if (__hip_atomic_load(cnt, RLX_AGENT) >= (unsigned)target) break; __builtin_amdgcn_s_sleep(2); }
        __builtin_amdgcn_fence(__ATOMIC_ACQUIRE, "agent"); VM_WAIT(); }
    __syncthreads();
}
DI void tail_arrive(unsigned* cnt, int tid0) {
    VM_WAIT(); __syncthreads();
    if (tid0 == 0) { __builtin_amdgcn_fence(__ATOMIC_RELEASE, "agent"); VM_WAIT(); __hip_atomic_fetch_add(cnt, 1u, RLX_AGENT); }
}
DI void tail_wait(unsigned* cnt, int tid0, int target) {
    if (tid0 == 0) { for (unsigned sp = 0; sp < (1u << 22); ++sp) { if (__hip_atomic_load(cnt, RLX_AGENT) >= (unsigned)target) break; __builtin_amdgcn_s_sleep(2); }
        __builtin_amdgcn_fence(__ATOMIC_ACQUIRE, "agent"); VM_WAIT(); }
    __syncthreads();
}
struct Args { const float* in[26]; float* out; unsigned char* ws; int ph_lo, ph_hi; };
template <int PHASE_MASK, int UNIT_MASK> __global__ void __launch_bounds__(NWAVES * 64, 2) fwd_kernel(Args args) {
    extern __shared__ __attribute__((aligned(16))) unsigned char lds_raw[];
    LAS unsigned char* lds = (LAS unsigned char*)lds_raw;
    volatile LAS unsigned* MISC = (volatile LAS unsigned*)(lds + MISC_OFF);
    const int tid0 = threadIdx.x, wid = __builtin_amdgcn_readfirstlane(tid0 >> 6);
    const int G = gridDim.x, bx = blockIdx.x, vcu = (G % 8 == 0) ? (bx % 8) * (G / 8) + bx / 8 : bx;
    const int gw = vcu * NWAVES + wid, NGW = G * NWAVES;
    typedef const __attribute__((address_space(4))) Args* kargs_t;
    const kargs_t kargs = (kargs_t)__builtin_amdgcn_kernarg_segment_ptr();
#define PH_BEGIN() kargs_t A = kargs; int tid = tid0; asm volatile("" : "+s"(A), "+v"(tid)); const int lane = tid & 63; unsigned char* const ws = A->ws; float* const out = A->out; (void)ws; (void)out; (void)lane
#define WSP(T, off) ((T*)(ws + (off)))
    const int lo = args.ph_lo, hi = args.ph_hi;
    for (int u = tid0; u < (LDS_BYTES - MISC_OFF) / 4; u += NWAVES * 64) ((LAS unsigned*)(lds + MISC_OFF))[u] = 0u;
    __syncthreads();
    XcdBarrier bar; bar.bar = (unsigned*)(args.ws + WS_CTL) + CW_BAR + lo * XCD_BAR_WORDS; bar.x = xb_xcc_id(); bar.st = nullptr;
    if (hi - lo > 1) bar = xcd_barrier_post((unsigned*)(args.ws + WS_CTL) + CW_BAR + lo * XCD_BAR_WORDS, MISC + 8);
#define UM(i) ((UNIT_MASK >> (i)) & 1)
#ifndef DUP_MASK
#define DUP_MASK 0
#endif
#ifndef PREP_FN
#define PREP_FN prep_unit2
#endif
#ifndef PROBE_SKIP
#define PROBE_SKIP 0
#endif
#ifndef DUP_UNITS
#define DUP_UNITS 0xff
#endif
#define UMR(i) (UM(i) && (rep == 0 || ((DUP_UNITS >> (i)) & 1)))
#define NREP(kind) (((DUP_MASK >> (kind)) & 1) ? 2 : 1)
#define KIND(k) ((k) == 0 ? 0 : ((k) - 1) % 9 + 1)
#define IN(k) (((PHASE_MASK >> KIND(k)) & 1) && lo <= (k) && (k) < hi)
#define SEAM(k) do { if (IN(k) && IN((k) + 1)) xcd_barrier_call(bar.bar, bar.x, bar.st); } while (0)
#define YROW(m) ((m) < MP ? out + O_YP + (size_t)(m) * D : out + O_YS + (size_t)((m) - MP) * D)
#define XROW(m) ((m) < MP ? A->in[0] + (size_t)(m) * D : A->in[1] + (size_t)((m) - MP) * D)

    if (IN(0)) { PH_BEGIN();
        bf16* WTIN = WSP(bf16, WS_WIN); bf16* WTOUT = WSP(bf16, WS_WOUT); bf16* WTF1 = WSP(bf16, WS_WF1); bf16* WTF2 = WSP(bf16, WS_WF2); bf16* WSG = WSP(bf16, WS_WSG); bf16* H = WSP(bf16, WS_H);
        LAS float* scr = (LAS float*)(lds + wid * 16384);
#pragma unroll 1
        for (int pass = 0; pass < 2; ++pass) {
        if (((pass ^ wid) & 1) == 0) {
        for (int it = gw; it < 12800; it += NGW) { const int l = it / 6400, r = it % 6400;
            if (r < 1664) p0_transpose_item<1>(A->in[8] + (size_t)l * D * DIN, D, DIN, NIN / 32, WTIN + (size_t)l * NIN * D, scr, r, lane);
            else if (r < 2176) p0_transpose_item<0>(A->in[20] + (size_t)l * D * D, D, D, D / 32, WTOUT + (size_t)l * D * D, scr, r - 1664, lane, A->in[14] + l * WA, WA);
            else if (r < 4992) p0_transpose_item<2>(A->in[23] + (size_t)l * D * NF1, D, NF1, NF1 / 32, WTF1 + (size_t)l * NF1 * D, scr, r - 2176, lane);
            else p0_transpose_item<0>(A->in[24] + (size_t)l * DFF * D, DFF, D, D / 32, WTF2 + (size_t)l * D * DFF, scr, r - 4992, lane); }
        } else
        for (int m = gw; m < M; m += 4 * NGW) rms_rows_to_bf16<4>(m, NGW, M, RowsF32Split{A->in[0], A->in[1]}, A->in[7], H, lane);
        }
        for (int i = bx * NWAVES * 64 + tid; i < 2 * 4 * 128 * 128; i += G * NWAVES * 64) { const int ii = (i >> 7) & 127, j = i & 127; WSG[i] = ((j >> 6) <= (ii >> 6)) ? f2bf(A->in[17][i]) : (bf16)0; }
    }
    SEAM(0);

    for (int l = 0; l < 2; ++l) {
        const int pb = 1 + 9 * l;
        for (int rep = 0; rep < NREP(1); ++rep) { if (rep) xcd_barrier_call(bar.bar, bar.x, bar.st);
        if (IN(pb)) { PH_BEGIN();
            bf16* H = WSP(bf16, WS_H); bf16* WTIN = WSP(bf16, WS_WIN);
            pg8::Gemm g{H, WTIN + (size_t)l * NIN * D, MP, NIN, D}; pg8::StaticOrder S; S.init(MP, NIN, G, bx);
            pg8::EpiIn E{WSP(bf16, WS_Q), WSP(bf16, WS_K), WSP(bf16, WS_V), WSP(bf16, WS_BQKV), WSP(bf16, WS_BZ), WSP(bf16, WS_CU), WSP(bf16, WS_CV), WSP(float, WS_SM), out + O_KP + (size_t)l * MP * WA, out + O_VP + (size_t)l * MP * WA, out + O_KS + (size_t)l * MS * WA, out + O_VS + (size_t)l * MS * WA, MP, QSCALE};
            pg8::gemm_phase<pg8::EpiIn, pg8::StaticOrder, true, true>(lds, g, S, E);
        }
        }
        SEAM(pb);
        for (int rep = 0; rep < NREP(2); ++rep) { if (rep) xcd_barrier_call(bar.bar, bar.x, bar.st);
        if (IN(pb + 1)) {
            if (UMR(1)) for (int u = bx; u < 48; u += G) { PH_BEGIN(); cumsum_unit(u, WSP(float, WS_SM), A->in[9] + l * NHA, out + O_LFP + (size_t)l * MP * NHA, WSP(float, WS_CL), lds, tid, lane, wid); }
            {
                LAS unsigned char* L = lds + wid * PREP_WAVE_LDS;
                if (UMR(5)) for (int u = vcu * NWAVES + wid; u < 6144; u += G * NWAVES) { PH_BEGIN(); PREP_FN(u, WSP(bf16, WS_BQKV), WSP(float, WS_SM), A->in[11] + l * NHB, A->in[12] + l * NHB, A->in[10] + (size_t)l * 4 * 1152, ws + WS_PREP, WSP(float, WS_GL), out + O_CVP + (size_t)l * NB * 3 * 1152, L, lane); }
            }
        }
        }
        SEAM(pb + 1);
#define QPOP(q) ({ if (tid0 == 0) { PH_BEGIN(); MISC[0] = __hip_atomic_fetch_add(WSP(unsigned, WS_CTL) + CW_QUEUE + 64 * (32 * l + 16 * rep + (q)), 1u, RLX_AGENT); } LDS_WAIT(); __syncthreads(); const int it_ = __builtin_amdgcn_readfirstlane((int)MISC[0]); __syncthreads(); it_; })
        for (int rep = 0; rep < NREP(3); ++rep) { if (rep) xcd_barrier_call(bar.bar, bar.x, bar.st);
        if (IN(pb + 2)) {
            constexpr int NINS = 2 * (NIN / 256);
#define CNTS (WSP(unsigned, WS_CTL) + CW_TAIL + 64 * (8 + l))
            if (rep == 0 && bx < NINS) { PH_BEGIN(); bf16* H = WSP(bf16, WS_H); bf16* WTIN = WSP(bf16, WS_WIN);
                pg8::Gemm g{H, WTIN + (size_t)l * NIN * D, M, NIN, D}; OneUnit S{MP / 256 + bx / (NIN / 256), bx % (NIN / 256)};
                pg8::EpiIn E{WSP(bf16, WS_Q), WSP(bf16, WS_K), WSP(bf16, WS_V), WSP(bf16, WS_BQKV), WSP(bf16, WS_BZ), WSP(bf16, WS_CU), WSP(bf16, WS_CV), WSP(float, WS_SM), out + O_KP + (size_t)l * MP * WA, out + O_VP + (size_t)l * MP * WA, out + O_KS + (size_t)l * MS * WA, out + O_VS + (size_t)l * MS * WA, MP, QSCALE};
                pg8::gemm_phase<pg8::EpiIn, OneUnit, true, true>(lds, g, S, E);
                tail_arrive(CNTS, tid0); }
            if (UMR(6)) for (int u = bx; u < 48; u += G) { PH_BEGIN(); scan_unit(u, ws + WS_PREP, WSP(float, WS_GL), WSP(bf16, WS_BZ), A->in[13] + l * HD, WSP(bf16, WS_CAT), out + O_SP + (size_t)l * NB * NHB * 4096, lds, tid, lane, wid); }
            if (UMR(7)) for (int xo = 0; xo < 8; ++xo) { const int xq = (int)((bar.x + (unsigned)xo) & 7u);
              for (;;) { const int qi = QPOP(8 + xq); if (qi >= 216) break;
                if (qi >= 50 && qi < 50 + 7 * 24 && (qi - 50) % 7 == 0) { PH_BEGIN(); tail_wait(CNTS, tid0, NINS); const int su = 24 * xq + (qi - 50) / 7;
                    sattn_unit(su / NHA, su % NHA, WSP(bf16, WS_Q), WSP(bf16, WS_K), WSP(bf16, WS_V), WSP(float, WS_SM), A->in[9] + l * NHA, out + O_LFS + (size_t)l * MS * NHA,
                               A->in[2] + (size_t)l * DB * PAST * WA, A->in[3] + (size_t)l * DB * PAST * WA, A->in[4] + (size_t)l * DB * PAST * NHA, WSP(bf16, WS_CAT), WSP(float, WS_SSQ), lds, tid, lane, wid); continue; }
                const int item = qi - (qi < 50 ? 0 : min((qi - 50) / 7 + 1, 24));
                { PH_BEGIN(); const int qb = 31 - item / 6, bh = 6 * xq + item % 6;
                  attn_body::attn_unit<40>(bh / NHA, bh % NHA, qb, WSP(const attn_body::bf16, WS_Q), WSP(const attn_body::bf16, WS_K), WSP(const attn_body::bf16, WS_V), WSP(attn_body::bf16, WS_CAT), WSP(float, WS_CL) + (size_t)bh * SEQ, (char*)lds_raw, WSP(float, WS_SSQ)); } } }
            if (UMR(0)) for (;;) { const int item = QPOP(0) + 192; if (item >= 192 + 24) break;
                if (item >= 192) { PH_BEGIN(); tail_wait(CNTS, tid0, NINS); const int u = (item - 192) * NWAVES + wid; LAS unsigned char* L = lds + wid * PREP_WAVE_LDS;
                    sgdn_unit(u / NHB, u % NHB, WSP(bf16, WS_BQKV), WSP(float, WS_SM), A->in[11][l * NHB + u % NHB], A->in[12][l * NHB + u % NHB], A->in[10] + (size_t)l * 4 * 1152,
                              A->in[5] + (size_t)l * DB * 3 * 1152, A->in[6] + (size_t)l * DB * NHB * 4096, WSP(bf16, WS_BZ), A->in[13] + l * HD, WSP(bf16, WS_CAT),
                              out + O_CVS + (size_t)l * DB * 3 * 1152, out + O_SS + (size_t)l * DB * NHB * 4096, L, lane);
                    LDS_WAIT(); __syncthreads(); }
 }
            if (UMR(2)) for (;;) { const int item = QPOP(2); if (item >= 544) break;
                if (item < 512) { PH_BEGIN(); sgate_unit(item, WSP(bf16, WS_CU), WSP(bf16, WS_CV), WSP(bf16, WS_WSG) + (size_t)l * 4 * 128 * 128, A->in[15] + l * WC, A->in[16] + l * WC, A->in[18] + l * 4 * 128, A->in[19] + l * WC, WSP(bf16, WS_CAT), lds, tid, lane, wid); }
                else { PH_BEGIN(); tail_wait(CNTS, tid0, NINS); sgate_sample_unit(item - 512, WSP(bf16, WS_CU), WSP(bf16, WS_CV), A->in[17] + (size_t)l * 4 * 128 * 128, A->in[15] + l * WC, A->in[16] + l * WC, A->in[18] + l * 4 * 128, A->in[19] + l * WC, WSP(bf16, WS_CAT),
                                                out + O_CS + (size_t)l * MS * WC, lds, tid); } }
        }
        }
#undef CNTS
        SEAM(pb + 2);
        for (int rep = 0; rep < NREP(5); ++rep) { if (rep) xcd_barrier_call(bar.bar, bar.x, bar.st);
        if (IN(pb + 4)) { PH_BEGIN(); bf16* CAT = WSP(bf16, WS_CAT); bf16* WTOUT = WSP(bf16, WS_WOUT); bf16* M1 = WSP(bf16, WS_M1);
            pg8::Gemm g{CAT, WTOUT + (size_t)l * D * D, MP, D, D, 0, WSP(float, WS_SSQ)}; pg8::StaticOrder S; S.init(MP, D, G, bx); pg8::EpiPlain E{M1, D};
            pg8::gemm_phase<pg8::EpiPlain, pg8::StaticOrder, true, true, true>(lds, g, S, E);
        }
        }
        SEAM(pb + 4);
        if (IN(pb + 5)) { PH_BEGIN(); int bxp = bx; asm volatile("" : "+s"(bxp));
            bf16* M1 = WSP(bf16, WS_M1); bf16* H = WSP(bf16, WS_H);
            bf16* XR = WSP(bf16, WS_XR);
            const RowsBf16 xr_of{XR};
            constexpr int NF1S = 2 * (NF1 / 256), R1 = 47616; static_assert(R1 % ((256 - NTAIL) * NWAVES) == 0 && R1 < MP, "row split");
            unsigned* cnt2 = WSP(unsigned, WS_CTL) + CW_TAIL + 64 * (4 + l);
            const bool tailwg = bxp < NTAIL, fwg = !tailwg && bxp < NTAIL + NF1S;
            if (tailwg) {
                bf16* CAT = WSP(bf16, WS_CAT); bf16* WTOUT = WSP(bf16, WS_WOUT);
                pg8::Gemm g{CAT + (size_t)MP * D, WTOUT + (size_t)l * D * D, MS, D, D, 0, WSP(float, WS_SSQ) + (size_t)MP * 8}; OneUnit S{bxp >> 2, bxp & 3}; pg8::EpiPlain E{M1 + (size_t)MP * D, D};
                pg8::gemm_phase<pg8::EpiPlain, OneUnit, true, true, true>(lds, g, S, E);
                tail_meet(WSP(unsigned, WS_CTL) + CW_TAIL + 64 * (2 * l), tid0);
            }
#pragma unroll 1
            for (int rg = 0; rg < 2; ++rg) { int r0, rstride, rend;
                if (tailwg) { r0 = MP + bxp * NWAVES + wid; rstride = NTAIL * NWAVES; rend = rg ? 0 : M; }
                else if (rg == 0) { r0 = (bxp - NTAIL) * NWAVES + wid; rstride = (G - NTAIL) * NWAVES; rend = R1; }
                else { r0 = R1 + (bxp - NTAIL - NF1S) * NWAVES + wid; rstride = (G - NTAIL - NF1S) * NWAVES; rend = fwg ? 0 : MP; }
                if (l == 0) { for (int m = r0; m < rend; m += 2 * rstride) norm_res_rows<true, false, 2>(m, rstride, rend, M1, RowsF32Split{A->in[0], A->in[1]}, xr_of, A->in[21] + l * D, A->in[22] + l * D, H, lane); }
                else { for (int m = r0; m < rend; m += 4 * rstride) norm_res_rows<false, false, 4>(m, rstride, rend, M1, xr_of, xr_of, A->in[21] + l * D, A->in[22] + l * D, H, lane); }
            }
            if (tailwg) tail_arrive(cnt2, tid0);
            if (fwg) { tail_wait(cnt2, tid0, NTAIL);
                bf16* WTF1 = WSP(bf16, WS_WF1); bf16* ACT = WSP(bf16, WS_ACT); const int fu = bxp - NTAIL;
                pg8::Gemm g{H, WTF1 + (size_t)l * NF1 * D, M, NF1, D}; OneUnit S{MP / 256 + fu / (NF1 / 256), fu % (NF1 / 256)}; pg8::EpiSwiglu E{ACT, DFF};
                pg8::gemm_phase<pg8::EpiSwiglu, OneUnit, true, true>(lds, g, S, E); }
        }
        SEAM(pb + 5);
        for (int rep = 0; rep < NREP(7); ++rep) { if (rep) xcd_barrier_call(bar.bar, bar.x, bar.st);
        if (IN(pb + 6)) { PH_BEGIN(); bf16* H = WSP(bf16, WS_H); bf16* WTF1 = WSP(bf16, WS_WF1); bf16* ACT = WSP(bf16, WS_ACT);
            pg8::Gemm g{H, WTF1 + (size_t)l * NF1 * D, MP, NF1, D}; pg8::StaticOrder S; S.init(MP, NF1, G, bx); pg8::EpiSwiglu E{ACT, DFF};
            pg8::gemm_phase<pg8::EpiSwiglu, pg8::StaticOrder, true, true>(lds, g, S, E);
        }
        }
        SEAM(pb + 6);
        for (int rep = 0; rep < NREP(8); ++rep) { if (rep) xcd_barrier_call(bar.bar, bar.x, bar.st);
        if (IN(pb + 7)) { PH_BEGIN(); bf16* ACT = WSP(bf16, WS_ACT); bf16* WTF2 = WSP(bf16, WS_WF2); bf16* M2 = WSP(bf16, WS_M2);
            pg8::Gemm g{ACT, WTF2 + (size_t)l * D * DFF, MP, D, DFF}; pg8::StaticOrder S; S.init(MP, D, G, bx); pg8::EpiPlain E{M2, D};
            pg8::gemm_phase<pg8::EpiPlain, pg8::StaticOrder, true, true>(lds, g, S, E);
        }
        }
        SEAM(pb + 7);
        if (IN(pb + 8)) { PH_BEGIN(); int bxp = bx; asm volatile("" : "+s"(bxp));
            bf16* M2 = WSP(bf16, WS_M2); bf16* H = WSP(bf16, WS_H);
            bf16* XR = WSP(bf16, WS_XR);
            const RowsBf16 xr_of{XR};
            constexpr int NT2 = 2 * NTAIL;
            if (G > NT2 && bxp < NT2) {
                bf16* ACT = WSP(bf16, WS_ACT); bf16* WTF2 = WSP(bf16, WS_WF2); float* PART = WSP(float, WS_PART);
                const int un = bxp & (NTAIL - 1), kh = bxp / NTAIL;
                pg8::Gemm g{ACT + (size_t)MP * DFF + kh * (DFF / 2), WTF2 + (size_t)l * D * DFF + kh * (DFF / 2), MS, D, DFF / 2, DFF}; OneUnit S{un >> 2, un & 3}; pg8::EpiF32 E{PART + (size_t)kh * MS * D, D};
                pg8::gemm_phase<pg8::EpiF32, OneUnit, true, true>(lds, g, S, E);
                tail_meet(WSP(unsigned, WS_CTL) + CW_TAIL + 64 * (2 * l + 1), tid0, NT2);
                const PairF32 m2s{PART, PART + (size_t)MS * D};
                const int r0 = MP + bxp * NWAVES + wid, rstride = NT2 * NWAVES;
                if (l == 0) { for (int m = r0; m < M; m += 2 * rstride) norm_res_rows<false, false, 2>(m, rstride, M, m2s, xr_of, xr_of, A->in[25] + l * D, A->in[7] + D, H, lane); }
                else { for (int m = r0; m < M; m += 2 * rstride) norm_res_rows<false, true, 2>(m, rstride, M, m2s, xr_of, RowsF32Split{out + O_YP, out + O_YS}, A->in[25] + l * D, (const float*)nullptr, H, lane); }
            } else {
                const int r0 = (bxp - NT2) * NWAVES + wid, rstride = (G - NT2) * NWAVES, rend = MP;
                if (l == 0) { for (int m = r0; m < rend; m += 4 * rstride) norm_res_rows<false, false, 4>(m, rstride, rend, M2, xr_of, xr_of, A->in[25] + l * D, A->in[7] + D, H, lane); }
                else { for (int m = r0; m < rend; m += 4 * rstride) norm_res_rows<false, true, 4>(m, rstride, rend, M2, xr_of, RowsF32Split{out + O_YP, out + O_YS}, A->in[25] + l * D, (const float*)nullptr, H, lane); }
            }
        }
        SEAM(pb + 8);
    }
#undef IN
#undef SEAM
}

#ifndef MK_PER_PHASE
#define MK_PER_PHASE 0
#endif
typedef void (*kern_t)(Args);
static void launch_one(kern_t k, int grid, Args a, int p, hipStream_t stream) {
    a.ph_lo = p; a.ph_hi = p + 1;
    hipLaunchKernelGGL(k, dim3(grid), dim3(NWAVES * 64), LDS_BYTES, stream, a);
}
extern "C" void kernel_launch(void* const* d_in, const int* in_sizes, int n_in, void* d_out, int out_size, void* d_ws, size_t ws_size, hipStream_t stream) {
    static int grid = 0;
#if MK_PER_PHASE
    static const kern_t kerns[] = { fwd_kernel<0x001, 0xff>, fwd_kernel<0x002, 0xff>, fwd_kernel<0x004, 0x02>, fwd_kernel<0x004, 0x10>, fwd_kernel<0x004, 0x20>,
                                    fwd_kernel<0x008, 0x40>, fwd_kernel<0x008, 0x01>, fwd_kernel<0x008, 0x80>, fwd_kernel<0x008, 0x04>, fwd_kernel<0x010, 0xff>, fwd_kernel<0x020, 0xff>, fwd_kernel<0x040, 0xff>, fwd_kernel<0x080, 0xff>, fwd_kernel<0x100, 0xff>, fwd_kernel<0x200, 0xff> };
    static const int kphase[] = { 0, 1, 2, 2, 2, 3, 3, 3, 3, 4, 5, 6, 7, 8, 9 };
    constexpr int NK = sizeof(kphase) / sizeof(int);
#else
    static const kern_t kerns[] = { fwd_kernel<0x3ff, 0xff> };
    constexpr int NK = 1;
#endif
    if (grid == 0) {
        if (n_in != 26 || (size_t)out_size != O_END || ws_size < WS_END) { fprintf(stderr, "kernel_launch: built for 26 inputs, %zu outputs, >= %zu bytes of workspace; got n_in %d, out %d, ws %zu; nothing launched\n", (size_t)O_END, (size_t)WS_END, n_in, out_size, ws_size); grid = -1; return; }
        int dev = 0, cus = 0;
        if (hipGetDevice(&dev) != hipSuccess || hipDeviceGetAttribute(&cus, hipDeviceAttributeMultiprocessorCount, dev) != hipSuccess) { fprintf(stderr, "kernel_launch: device query failed\n"); grid = -1; return; }
        for (int i = 0; i < NK; ++i)
            if (hipFuncSetAttribute((const void*)kerns[i], hipFuncAttributeMaxDynamicSharedMemorySize, LDS_BYTES) != hipSuccess) { fprintf(stderr, "kernel_launch: hipFuncSetAttribute(%d B LDS) failed for kernel %d\n", LDS_BYTES, i); grid = -1; return; }
        (void)hipGetLastError();
        grid = cus;
    }
    if (grid < 0) return;
    if (hipMemsetAsync((char*)d_ws + WS_CTL, 0, CTL_ZERO_BYTES, stream) != hipSuccess) { fprintf(stderr, "kernel_launch: memset failed\n"); return; }
    Args a{};
    for (int i = 0; i < 26; ++i) a.in[i] = (const float*)d_in[i];
    a.out = (float*)d_out; a.ws = (unsigned char*)d_ws;
#if MK_PER_PHASE
    launch_one(kerns[0], grid, a, 0, stream);
    for (int l = 0; l < 2; ++l) for (int i = 1; i < NK; ++i) launch_one(kerns[i], grid, a, 9 * l + kphase[i], stream);
#elif defined(MK_CUTS)
    { static const int cuts[] = {MK_CUTS}; constexpr int NC = sizeof(cuts) / sizeof(int); for (int i = 0; i + 1 < NC; ++i) { a.ph_lo = cuts[i]; a.ph_hi = cuts[i + 1]; hipLaunchKernelGGL(kerns[0], dim3(grid), dim3(NWAVES * 64), LDS_BYTES, stream, a); } }
#else
    a.ph_lo = 0; a.ph_hi = N_PHASES;
    hipLaunchKernelGGL(kerns[0], dim3(grid), dim3(NWAVES * 64), LDS_BYTES, stream, a);
#endif
    const hipError_t le = hipPeekAtLastError();
    if (le != hipSuccess) fprintf(stderr, "kernel_launch: launch failed: %s\n", hipGetErrorName(le));
}
```
